# Optimizing an MI355X kernel written in HIP

```python
import math
import jax
import jax.numpy as jnp
from jax import lax
import numpy as np

D_MODEL = 2048
BATCH = 4
SEQ = 8192
DEPTH = 2
DEC_BATCH = 2
DEC_SEQ = 16384
PAST_LEN = 128

HEAD_DIM = 64
A_HEADS = 12
A_BRANCHES = ((128, 1), (512, 4), (2048, 16))
A_BLOCK = 64
R_HEADS = 8
R_QK_DIM = 32
R_V_DIM = 64
R_CHUNK = 128
ROPE_BASE = 10000.0
C_HEADS = 12
C_KV_HEADS = 4
C_GROUP = C_HEADS // C_KV_HEADS
C_RADIUS = 128
C_BLOCK = 128
REL_BUCKETS = 32
REL_MAX_DIST = 1024
D_FF = ((8 * D_MODEL + 3 * 256 - 1) // (3 * 256)) * 256
A_W = A_HEADS * HEAD_DIM
R_QK_W = R_HEADS * R_QK_DIM
R_W = R_HEADS * R_V_DIM
C_W = C_HEADS * HEAD_DIM
C_KV_W = C_KV_HEADS * HEAD_DIM
MIX_W = A_W + R_W + C_W
SPLIT_SIZES = (A_W, A_W, A_W, R_QK_W, R_QK_W, R_W, R_W, C_W, C_KV_W, C_KV_W)
IN_COLS = 3 * A_W + 2 * R_QK_W + 2 * R_W + C_W + 2 * C_KV_W
EPS = 1e-6
GN_EPS = 1e-5
NEG = -1e30

kernel_name = 'hybrid_dilated_retention_swa_encoder'


def rms_norm(x, g):
    xf = x.astype(jnp.float32)
    y = xf * lax.rsqrt(jnp.mean(xf * xf, axis=-1, keepdims=True) + EPS) * g.astype(jnp.float32)
    return y.astype(x.dtype)


def t5_bucket(rel):
    nb = REL_BUCKETS // 2
    max_exact = nb // 2
    ret = np.where(rel > 0, nb, 0)
    n = np.abs(rel)
    nf = np.maximum(n, 1).astype(np.float32)
    large = max_exact + (np.log(nf / max_exact) / math.log(REL_MAX_DIST / max_exact) * (nb - max_exact)).astype(np.int32)
    large = np.minimum(large, nb - 1)
    return (ret + np.where(n < max_exact, n, large)).astype(np.int32)


def rel_bias(table, bucket):
    return jnp.take(table.astype(jnp.float32), jnp.asarray(bucket), axis=0).transpose(2, 0, 1)


def dilated_branch(q, k, v, window, dil, bias_tab):
    B, S, H, Dh = q.shape
    R = window // (2 * dil)
    L = S // dil
    nblk = -(-L // A_BLOCK)
    Lp = nblk * A_BLOCK
    pad = Lp - L

    def sub(t):
        return t.reshape(B, L, dil, H, Dh).transpose(0, 2, 1, 3, 4)

    qs = jnp.pad(sub(q), ((0, 0), (0, 0), (0, pad), (0, 0), (0, 0))).reshape(B, dil, nblk, A_BLOCK, H, Dh)

    def windows(t):
        tp = jnp.pad(sub(t), ((0, 0), (0, 0), (A_BLOCK, pad + A_BLOCK), (0, 0), (0, 0)))
        tp = tp.reshape(B, dil, nblk + 2, A_BLOCK, H, Dh)
        return jnp.concatenate([tp[:, :, :-2], tp[:, :, 1:-1], tp[:, :, 2:]], axis=3)

    kw, vw = windows(k), windows(v)
    qq = np.arange(A_BLOCK)[:, None]
    kk = np.arange(3 * A_BLOCK)[None, :]
    off = kk - A_BLOCK - qq
    kpos = np.arange(nblk)[:, None, None] * A_BLOCK + kk[None] - A_BLOCK
    valid = (np.abs(off) <= R)[None] & (kpos >= 0) & (kpos < L)
    bias = rel_bias(bias_tab, t5_bucket(off * dil))
    s = jnp.einsum('bdnqhe,bdnkhe->bdnhqk', qs, kw, preferred_element_type=jnp.float32) * (HEAD_DIM ** -0.5) + bias
    s = jnp.where(jnp.asarray(valid)[:, None], s, NEG)
    m = jnp.max(s, axis=-1)
    p = jnp.exp(s - m[..., None])
    l = jnp.sum(p, axis=-1)
    num = jnp.einsum('bdnhqk,bdnkhe->bdnqhe', p, vw.astype(jnp.float32))
    num = num.reshape(B, dil, Lp, H, Dh)[:, :, :L].transpose(0, 2, 1, 3, 4).reshape(B, S, H, Dh)

    def back(t):
        t = t.transpose(0, 1, 2, 4, 3).reshape(B, dil, Lp, H)[:, :, :L]
        return t.transpose(0, 2, 1, 3).reshape(B, S, H)

    return num, back(m), back(l)


def dilated_attention(q, k, v, bias_tab):
    parts = [dilated_branch(q, k, v, w, d, bias_tab) for (w, d) in A_BRANCHES]
    M = parts[0][1]
    for _, m, _ in parts[1:]:
        M = jnp.maximum(M, m)
    num = 0.0
    den = 0.0
    for n_i, m_i, l_i in parts:
        w_i = jnp.exp(m_i - M)
        num = num + n_i * w_i[..., None]
        den = den + l_i * w_i
    return num / den[..., None]


def rope(x, pos):
    half = R_QK_DIM // 2
    freqs = ROPE_BASE ** (-jnp.arange(half, dtype=jnp.float32) / half)
    ang = pos[:, None] * freqs[None]
    cos = jnp.cos(ang)[None, :, None, :]
    sin = jnp.sin(ang)[None, :, None, :]
    x1, x2 = x[..., :half], x[..., half:]
    return jnp.concatenate([x1 * cos - x2 * sin, x1 * sin + x2 * cos], axis=-1)


def retention_dir(q, k, v, lg, inclusive):
    B, S, H, dk = q.shape
    dv = v.shape[-1]
    C = R_CHUNK
    n = S // C
    qc = q.reshape(B, n, C, H, dk)
    kc = k.reshape(B, n, C, H, dk)
    vc = v.reshape(B, n, C, H, dv)
    t = np.arange(C)
    diff = t[:, None] - t[None, :]
    mask = (diff >= 0) if inclusive else (diff > 0)
    decay = jnp.where(jnp.asarray(mask)[None], jnp.exp(lg[:, None, None] * np.maximum(diff, 0).astype(np.float32)), 0.0)
    s = jnp.einsum('bnthd,bnshd->bnhts', qc, kc) * decay
    intra = jnp.einsum('bnhts,bnshe->bnthe', s, vc)
    tf = t.astype(np.float32)
    kdec = jnp.exp(lg[None, :] * (C - 1 - tf)[:, None])
    kv = jnp.einsum('bnshd,sh,bnshe->bnhde', kc, kdec, vc)
    g_chunk = jnp.exp(lg * C)

    def step(R, kv_i):
        return R * g_chunk[:, None, None] + kv_i, R

    _, r_prev = lax.scan(step, jnp.zeros((B, H, dk, dv), jnp.float32), kv.transpose(1, 0, 2, 3, 4))
    r_prev = r_prev.transpose(1, 0, 2, 3, 4)
    qdec = jnp.exp(lg[None, :] * (tf + 1.0)[:, None])
    cross = jnp.einsum('bnthd,th,bnhde->bnthe', qc, qdec, r_prev)
    return (intra + cross).reshape(B, S, H, dv)


def bidir_retention(q, k, v, gate, a_fwd, a_bwd):
    B, S, H, _ = q.shape
    pos = jnp.arange(S, dtype=jnp.float32)
    q = rope(q.astype(jnp.float32), pos)
    k = rope(k.astype(jnp.float32), pos) * (R_QK_DIM ** -0.5)
    v = v.astype(jnp.float32)
    lg_f = jnp.log1p(-jnp.exp2(-a_fwd.astype(jnp.float32)))
    lg_b = jnp.log1p(-jnp.exp2(-a_bwd.astype(jnp.float32)))
    fwd = retention_dir(q, k, v, lg_f, True)
    bwd = jnp.flip(retention_dir(jnp.flip(q, 1), jnp.flip(k, 1), jnp.flip(v, 1), lg_b, False), 1)
    o = fwd + bwd
    mu = jnp.mean(o, axis=-1, keepdims=True)
    var = jnp.mean(jnp.square(o - mu), axis=-1, keepdims=True)
    o = (o - mu) * lax.rsqrt(var + GN_EPS)
    return o.reshape(B, S, H * R_V_DIM) * jax.nn.silu(gate.astype(jnp.float32))


def window_gqa_sink(q, k, v, bias_tab, sink):
    B, S, _, Dh = q.shape
    nblk = S // C_BLOCK
    qb = q.reshape(B, nblk, C_BLOCK, C_KV_HEADS, C_GROUP, Dh)

    def windows(t):
        tp = jnp.pad(t, ((0, 0), (C_BLOCK, C_BLOCK), (0, 0), (0, 0))).reshape(B, nblk + 2, C_BLOCK, C_KV_HEADS, Dh)
        return jnp.concatenate([tp[:, :-2], tp[:, 1:-1], tp[:, 2:]], axis=2)

    kw, vw = windows(k), windows(v)
    qq = np.arange(C_BLOCK)[:, None]
    kk = np.arange(3 * C_BLOCK)[None, :]
    off = kk - C_BLOCK - qq
    kpos = np.arange(nblk)[:, None, None] * C_BLOCK + kk[None] - C_BLOCK
    valid = (np.abs(off) <= C_RADIUS)[None] & (kpos >= 0) & (kpos < S)
    bias = rel_bias(bias_tab, t5_bucket(off)).reshape(C_KV_HEADS, C_GROUP, C_BLOCK, 3 * C_BLOCK)
    s = jnp.einsum('bnqhge,bnkhe->bnhgqk', qb, kw, preferred_element_type=jnp.float32) * (HEAD_DIM ** -0.5) + bias
    s = jnp.where(jnp.asarray(valid)[:, None, None], s, NEG)
    sk = sink.astype(jnp.float32).reshape(C_KV_HEADS, C_GROUP)[:, :, None]
    m = jnp.maximum(jnp.max(s, axis=-1), sk)
    p = jnp.exp(s - m[..., None])
    den = jnp.sum(p, axis=-1) + jnp.exp(sk - m)
    o = jnp.einsum('bnhgqk,bnkhe->bnqhge', p, vw.astype(jnp.float32))
    o = o / den.transpose(0, 1, 4, 2, 3)[..., None]
    return o.reshape(B, S, C_W)


def encoder_layer(x, bias_tab, g1, w_in, a_fwd, a_bwd, sink, w_out, g2, w_gate, w_up, w_down):
    B, S, _ = x.shape
    h = rms_norm(x, g1)
    proj = h @ w_in
    idx = []
    acc = 0
    for sz in SPLIT_SIZES[:-1]:
        acc += sz
        idx.append(acc)
    qa, ka, va, qr, kr, vr, gr, qc, kc, vc = jnp.split(proj, idx, axis=-1)
    a = dilated_attention(qa.reshape(B, S, A_HEADS, HEAD_DIM), ka.reshape(B, S, A_HEADS, HEAD_DIM),
                          va.reshape(B, S, A_HEADS, HEAD_DIM), bias_tab[:, :A_HEADS]).reshape(B, S, A_W)
    r = bidir_retention(qr.reshape(B, S, R_HEADS, R_QK_DIM), kr.reshape(B, S, R_HEADS, R_QK_DIM),
                        vr.reshape(B, S, R_HEADS, R_V_DIM), gr, a_fwd, a_bwd)
    c = window_gqa_sink(qc.reshape(B, S, C_HEADS, HEAD_DIM), kc.reshape(B, S, C_KV_HEADS, HEAD_DIM),
                        vc.reshape(B, S, C_KV_HEADS, HEAD_DIM), bias_tab[:, A_HEADS:], sink)
    mix = jnp.concatenate([a, r, c], axis=-1).astype(x.dtype) @ w_out
    x = x + mix
    h = rms_norm(x, g2)
    x = x + (jax.nn.silu(h @ w_gate) * (h @ w_up)) @ w_down
    return x


def setup_inputs(seed: int = 0) -> dict:
    key = jax.random.key(seed)
    ks = jax.random.split(key, 14)
    f32 = jnp.float32
    base_decay = 5.0 + jnp.arange(R_HEADS, dtype=f32)
    return {
        'x_prompt': jax.random.normal(ks[0], (BATCH, SEQ, D_MODEL), f32),
        'x_sample': jax.random.normal(ks[1], (DEC_BATCH, DEC_SEQ, D_MODEL), f32),
        'rel_bias': 0.5 * jax.random.normal(ks[2], (REL_BUCKETS, A_HEADS + C_HEADS), f32),
        'norm1_g': 1.0 + 0.01 * jax.random.normal(ks[3], (DEPTH, D_MODEL), f32),
        'w_in': jax.random.normal(ks[4], (DEPTH, D_MODEL, IN_COLS), f32) * D_MODEL ** -0.5,
        'ret_decay_fwd': base_decay + 0.1 * jax.random.normal(ks[5], (DEPTH, R_HEADS), f32),
        'ret_decay_bwd': base_decay + 0.1 * jax.random.normal(ks[6], (DEPTH, R_HEADS), f32),
        'attn_sink': 0.5 * jax.random.normal(ks[7], (DEPTH, C_HEADS), f32),
        'w_out': jax.random.normal(ks[8], (DEPTH, MIX_W, D_MODEL), f32) * MIX_W ** -0.5,
        'norm2_g': 1.0 + 0.01 * jax.random.normal(ks[9], (DEPTH, D_MODEL), f32),
        'w_gate': jax.random.normal(ks[10], (DEPTH, D_MODEL, D_FF), f32) * D_MODEL ** -0.5,
        'w_up': jax.random.normal(ks[11], (DEPTH, D_MODEL, D_FF), f32) * D_MODEL ** -0.5,
        'w_down': jax.random.normal(ks[12], (DEPTH, D_FF, D_MODEL), f32) * D_FF ** -0.5,
        'final_norm_g': 1.0 + 0.01 * jax.random.normal(ks[13], (D_MODEL,), f32),
    }


def reference(x_prompt, x_sample, rel_bias, norm1_g, w_in, ret_decay_fwd, ret_decay_bwd, attn_sink,
              w_out, norm2_g, w_gate, w_up, w_down, final_norm_g):
    def trunk(x):
        for i in range(DEPTH):
            x = encoder_layer(x, rel_bias, norm1_g[i], w_in[i], ret_decay_fwd[i], ret_decay_bwd[i],
                              attn_sink[i], w_out[i], norm2_g[i], w_gate[i], w_up[i], w_down[i])
        return rms_norm(x, final_norm_g)

    y_prompt = trunk(x_prompt)
    y_sample = trunk(x_sample)
    return (y_prompt, y_sample)
```

```cpp
#include <hip/hip_runtime.h>
#include <hip/hip_cooperative_groups.h>
#include <cstdio>
#include <cstdint>
namespace cg = cooperative_groups;
__device__ __forceinline__ float shx(float v, int mask, int lane) { return __builtin_bit_cast(float, __builtin_amdgcn_ds_bpermute((lane ^ mask) << 2, __builtin_bit_cast(int, v))); }
namespace pg8 {
#define PG8_LAS __attribute__((address_space(3)))
typedef unsigned short bf16_t;
typedef short bf16x8 __attribute__((ext_vector_type(8)));
typedef float f32x4 __attribute__((ext_vector_type(4)));
typedef unsigned u32x4 __attribute__((ext_vector_type(4)));
constexpr int BM = 256, BK = 64, HALF = 128, HTB = HALF * BK * 2  , STAGE_BYTES = 8 * HTB, NXCD = 8, WGM = 8;

__host__ __device__ __forceinline__ int lds_byte(int r, int c) { const int st = (r >> 4) * 2 + (c >> 5), rr = r & 15, cc = c & 31, ob = rr * 64 + cc * 2; return st * 1024 + (ob ^ (((ob >> 9) & 1) << 5)); }
__host__ __device__ __forceinline__ void stage_rc(int b, int& R, int& C) { const int st = b / 1024, sb = b % 1024, swz = sb ^ (((sb >> 9) & 1) << 5); R = (st >> 1) * 16 + swz / 64; C = (st & 1) * 32 + (swz % 64) / 2; }
__host__ __device__ __forceinline__ int perm32(int rho) { const int n = rho >> 4, i = rho & 15; return 8 * (i >> 2) + 4 * n + (i & 3); }

struct Unit { int pm, pn; };
struct Gemm { const bf16_t* A; const bf16_t* Bt; int M, N, K; };

struct StaticOrder {
    int nM, nN, nwg, G, c;
    __host__ __device__ void init(int M, int N, int G_, int c_) { nM = M / BM; nN = N / BM; nwg = nM * nN; G = G_; c = c_; }
    __host__ __device__ bool next(int i, Unit& u) const {
        const long L = (long)i * G + c; if (L >= nwg) return false;
        int wgid = (int)L; { const int q = nwg / NXCD, r = nwg % NXCD, xcd = wgid % NXCD, off = wgid / NXCD; wgid = (xcd < r ? xcd * (q + 1) : r * (q + 1) + (xcd - r) * q) + off; }
        const int nig = WGM * nN, gid = wgid / nig, fm = gid * WGM, gsz = (nM - fm) < WGM ? (nM - fm) : WGM;
        u.pm = fm + ((wgid % nig) % gsz); u.pn = (wgid % nig) / gsz; return true;
    }
    __device__ __forceinline__ void a_ready(const Unit&) const {}
    __device__ __forceinline__ void done(const Unit&) const {}
};

__device__ __forceinline__ unsigned cvt_pk_bf16(float lo, float hi) { unsigned r; asm volatile("s_nop 0\n\tv_cvt_pk_bf16_f32 %0, %1, %2" : "=v"(r) : "v"(lo), "v"(hi)); return r; }
typedef __bf16 bf16x2_t __attribute__((ext_vector_type(2)));
typedef float f32x2_t __attribute__((ext_vector_type(2)));
__device__ __forceinline__ unsigned cvt_pk_vis(float lo, float hi) { const f32x2_t f = {lo, hi}; const bf16x2_t v = __builtin_convertvector(f, bf16x2_t); return __builtin_bit_cast(unsigned, v); }
typedef float f32x2 __attribute__((ext_vector_type(2)));
typedef unsigned u32x2 __attribute__((ext_vector_type(2)));
constexpr float RMS_EPS = 1e-6f;
__device__ __forceinline__ void rows_rstd(const float* part, int M, int row0, int fr, int fq, float (&rs)[8]) {
    float s[8];
#pragma unroll
    for (int r = 0; r < 8; ++r) { const float* p = part + (size_t)(fq * 8) * M + row0 + (r >> 2) * HALF + (r & 3) * 16; float a = 0.f;
#pragma unroll
        for (int i = 0; i < 8; ++i) a += p[(size_t)i * M];
        s[r] = a; }
#pragma unroll
    for (int r = 0; r < 8; ++r) s[r] += shx(s[r], 16, (fr | (fq << 4)));
#pragma unroll
    for (int r = 0; r < 8; ++r) s[r] += shx(s[r], 32, (fr | (fq << 4)));
#pragma unroll
    for (int r = 0; r < 8; ++r) rs[r] = rsqrtf(s[r] * (1.0f / 2048.0f) + RMS_EPS);
}
struct EpiScaleBf16 {
    static constexpr bool PERM = true, AFTER_DRAIN = false;
    bf16_t* O; int ldc; const float* part; int M;
    __device__ __forceinline__ void operator()(const f32x4 (&acc)[2][2][4][2], const Unit& u, int wr, int wc, int fr, int fq) const {
        const int row0 = u.pm * BM + wr * 64 + fr; const int col0 = u.pn * BM + wc * 32 + 8 * fq;
        float rs8[8]; rows_rstd(part, M, row0, fr, fq, rs8);
#pragma unroll
        for (int ai = 0; ai < 2; ++ai)
#pragma unroll
            for (int m = 0; m < 4; ++m) { const int row = row0 + ai * HALF + m * 16; const float rs = rs8[ai * 4 + m];
                bf16_t* rowp = O + (size_t)row * ldc + col0;
#pragma unroll
                for (int bj = 0; bj < 2; ++bj) { const f32x4 v0 = acc[ai][bj][m][0] * rs, v1 = acc[ai][bj][m][1] * rs;
                    u32x4 w; w.x = cvt_pk_bf16(v0[0], v0[1]); w.y = cvt_pk_bf16(v0[2], v0[3]); w.z = cvt_pk_bf16(v1[0], v1[1]); w.w = cvt_pk_bf16(v1[2], v1[3]);
                    *(u32x4*)(rowp + bj * HALF) = w; } }
    }
};
__device__ __forceinline__ float silu_mul(float g, float u) { return g * u * __builtin_amdgcn_rcpf(1.0f + __expf(-g)); }
struct EpiSwiGLU {
    static constexpr bool PERM = true, AFTER_DRAIN = false;
    bf16_t* H; int ldh; const float* part; int M;
    __device__ __forceinline__ void operator()(const f32x4 (&acc)[2][2][4][2], const Unit& u, int wr, int wc, int fr, int fq) const {
        const int row0 = u.pm * BM + wr * 64 + fr; const int col0 = u.pn * HALF + wc * 32 + 8 * fq;
        float rs8[8]; rows_rstd(part, M, row0, fr, fq, rs8);
#pragma unroll
        for (int ai = 0; ai < 2; ++ai)
#pragma unroll
            for (int m = 0; m < 4; ++m) { const int row = row0 + ai * HALF + m * 16; const float rs = rs8[ai * 4 + m];
                const f32x4 g0 = acc[ai][0][m][0] * rs, g1 = acc[ai][0][m][1] * rs, u0 = acc[ai][1][m][0] * rs, u1 = acc[ai][1][m][1] * rs;
                u32x4 w; w.x = cvt_pk_bf16(silu_mul(g0[0], u0[0]), silu_mul(g0[1], u0[1])); w.y = cvt_pk_bf16(silu_mul(g0[2], u0[2]), silu_mul(g0[3], u0[3]));
                w.z = cvt_pk_bf16(silu_mul(g1[0], u1[0]), silu_mul(g1[1], u1[1])); w.w = cvt_pk_bf16(silu_mul(g1[2], u1[2]), silu_mul(g1[3], u1[3]));
                *(u32x4*)(H + (size_t)row * ldh + col0) = w; }
    }
};
struct EpiResid {
    static constexpr bool PERM = false, AFTER_DRAIN = false;
    bf16_t* xb; float* part; int M;
    __device__ __forceinline__ void operator()(const f32x4 (&acc)[2][2][4][2], const Unit& u, int wr, int wc, int fr, int fq) const {
        const int row0 = u.pm * BM + wr * 64 + fr; const int col0 = u.pn * BM + wc * 32 + 4 * fq;
        u32x2 bw[2][4][2][2];
#pragma unroll
        for (int ai = 0; ai < 2; ++ai)
#pragma unroll
            for (int m = 0; m < 4; ++m)
#pragma unroll
                for (int bj = 0; bj < 2; ++bj)
#pragma unroll
                    for (int n = 0; n < 2; ++n) bw[ai][m][bj][n] = *(const u32x2*)(xb + (size_t)(row0 + ai * HALF + m * 16) * 2048 + col0 + bj * HALF + n * 16);
        asm volatile("" ::: "memory");
#pragma unroll
        for (int ai = 0; ai < 2; ++ai)
#pragma unroll
            for (int m = 0; m < 4; ++m) { const int row = row0 + ai * HALF + m * 16; const size_t off = (size_t)row * 2048 + col0; float ss = 0.f;
#pragma unroll
                for (int bj = 0; bj < 2; ++bj)
#pragma unroll
                    for (int n = 0; n < 2; ++n) { const u32x2 b = bw[ai][m][bj][n]; f32x4 v = acc[ai][bj][m][n];
                        v[0] += __uint_as_float(b.x << 16); v[1] += __uint_as_float(b.x & 0xffff0000u); v[2] += __uint_as_float(b.y << 16); v[3] += __uint_as_float(b.y & 0xffff0000u);
                        ss += (v[0] * v[0] + v[1] * v[1]) + (v[2] * v[2] + v[3] * v[3]);
                        u32x2 w; w.x = cvt_pk_bf16(v[0], v[1]); w.y = cvt_pk_bf16(v[2], v[3]); *(u32x2*)(xb + off + bj * HALF + n * 16) = w; }
                ss += shx(ss, 16, (fr | (fq << 4))); ss += shx(ss, 32, (fr | (fq << 4)));
                if (fq == 0) part[(size_t)(u.pn * 4 + wc) * M + row] = ss; }
    }
};
template <class Epi, class Sched, bool ALIGN_EPI = false, bool SP2 = false>
__device__ __forceinline__ void gemm_phase(PG8_LAS unsigned char* lds, const Gemm g, const Sched& S, const Epi& E, int tid_in) {
    int tid_ = tid_in; asm volatile("" : "+v"(tid_));
    const int tid = tid_, wid = __builtin_amdgcn_readfirstlane(tid >> 6), lane = tid & 63, wr = wid >> 2, wc = wid & 3, fr = lane & 15, fq = lane >> 4;
    int K_ = g.K; asm volatile("" : "+s"(K_));
    const int K = K_, nt = K / BK;
    unsigned voffA[2], voffB[2];
#pragma unroll
    for (int i = 0; i < 2; ++i) { int R, C; stage_rc(tid * 16 + i * 8192, R, C); const int Rb = Epi::PERM ? ((R & ~31) + perm32(R & 31)) : R;
        voffA[i] = (unsigned)(R * K + C) * 2u; voffB[i] = (unsigned)(Rb * K + C) * 2u; }
    const size_t kstep = (size_t)(BK * 2);
    const size_t hstep = (size_t)HALF * K * 2;
    const size_t tstep = 2 * hstep;
    const unsigned ldsw = (unsigned)wid * 1024u;
    const int aoff = lds_byte(wr * 64 + fr, fq * 8), boff = lds_byte(wc * 32 + fr, fq * 8);
#define PG8_SA(b, h) (((b) * 2 + (h)) * HTB)
#define PG8_SB(b, h) ((4 + (b) * 2 + (h)) * HTB)
#define PG8_STAGE(bufoff, gbase, voff) do { _Pragma("unroll") for (int _i = 0; _i < 2; ++_i) \
        __builtin_amdgcn_global_load_lds((const unsigned*)((const char*)(gbase) + (voff)[_i]), (PG8_LAS unsigned*)(lds + (bufoff) + ldsw + _i * 8192), 16, 0, 0); } while (0)
#define PG8_LDA(dst, b, h) do { _Pragma("unroll") for (int m = 0; m < 4; ++m) _Pragma("unroll") for (int k = 0; k < 2; ++k) dst[m][k] = *(const PG8_LAS bf16x8*)(lds + PG8_SA(b, h) + aoff + m * 2048 + k * 1024); } while (0)
#define PG8_LDB(dst, b, h) do { _Pragma("unroll") for (int n = 0; n < 2; ++n) _Pragma("unroll") for (int k = 0; k < 2; ++k) dst[n][k] = *(const PG8_LAS bf16x8*)(lds + PG8_SB(b, h) + boff + n * 2048 + k * 1024); } while (0)
#define PG8_MMA(ai, bj, At, Bt) do { __builtin_amdgcn_s_setprio(1); _Pragma("unroll") for (int m = 0; m < 4; ++m) _Pragma("unroll") for (int n = 0; n < 2; ++n) _Pragma("unroll") for (int k = 0; k < 2; ++k) \
        acc[ai][bj][m][n] = __builtin_amdgcn_mfma_f32_16x16x32_bf16(Bt[n][k], At[m][k], acc[ai][bj][m][n], 0, 0, 0); __builtin_amdgcn_s_setprio(0); } while (0)
#define PG8_WAIT_V(n) asm volatile("s_waitcnt vmcnt(" #n ")" ::: "memory")
#define PG8_WAIT_L(n) asm volatile("s_waitcnt lgkmcnt(" #n ")" ::: "memory")
#define PG8_BAR __builtin_amdgcn_s_barrier()
#define PG8_SCHED __builtin_amdgcn_sched_barrier(0)
    Unit cur, nxt; int ui = 0;
    if (!S.next(0, cur)) return;
    f32x4 acc[2][2][4][2];
#pragma unroll
    for (int a = 0; a < 2; ++a)
#pragma unroll
        for (int b = 0; b < 2; ++b)
#pragma unroll
            for (int m = 0; m < 4; ++m)
#pragma unroll
                for (int n = 0; n < 2; ++n) acc[a][b][m][n] = (f32x4){0.f, 0.f, 0.f, 0.f};
    bf16x8 At[4][2], B0[2][2], B1[2][2];
    const char* cA = (const char*)g.A + (size_t)cur.pm * tstep; const char* cB = (const char*)g.Bt + (size_t)cur.pn * tstep;
    S.a_ready(cur);
    if constexpr (SP2) {
        PG8_STAGE(PG8_SB(0, 0), cB, voffB); PG8_STAGE(PG8_SB(0, 1), cB + hstep, voffB); PG8_STAGE(PG8_SA(0, 0), cA, voffA); PG8_STAGE(PG8_SA(0, 1), cA + hstep, voffA);
        if (wr == 1) PG8_BAR;
        PG8_WAIT_V(2); PG8_BAR;
        PG8_STAGE(PG8_SB(1, 0), cB + kstep, voffB); PG8_STAGE(PG8_SA(1, 0), cA + kstep, voffA); PG8_STAGE(PG8_SB(1, 1), cB + hstep + kstep, voffB);
        PG8_WAIT_V(6); PG8_BAR;
    } else {
        PG8_STAGE(PG8_SB(0, 0), cB, voffB); PG8_STAGE(PG8_SA(0, 0), cA, voffA); PG8_STAGE(PG8_SB(0, 1), cB + hstep, voffB); PG8_STAGE(PG8_SA(0, 1), cA + hstep, voffA);
        if (wr == 1) PG8_BAR;
        PG8_WAIT_V(4); PG8_BAR;
        PG8_STAGE(PG8_SB(1, 0), cB + kstep, voffB); PG8_STAGE(PG8_SA(1, 0), cA + kstep, voffA); PG8_STAGE(PG8_SB(1, 1), cB + hstep + kstep, voffB);
        PG8_WAIT_V(6); PG8_BAR;
    }
    for (;;) {
        const bool has_next = S.next(ui + 1, nxt);
        const char* nA = has_next ? (const char*)g.A + (size_t)nxt.pm * tstep : cA; const char* nB = has_next ? (const char*)g.Bt + (size_t)nxt.pn * tstep : cB;
        for (int t = 0; t < nt; t += 2) {
            const bool last = (t == nt - 2);
            const char* a1 = cA + (size_t)(t + 1) * kstep;
            const char* a2 = last ? nA : cA + (size_t)(t + 2) * kstep; const char* b2 = last ? nB : cB + (size_t)(t + 2) * kstep;
            const char* a3 = a2 + kstep; const char* b3 = b2 + kstep;
            if (last && has_next) S.a_ready(nxt);
            if constexpr (SP2) {
            PG8_LDB(B0, 0, 0); PG8_LDB(B1, 0, 1); PG8_SCHED; PG8_LDA(At, 0, 0); PG8_STAGE(PG8_SA(1, 1), a1 + hstep, voffA);
            PG8_WAIT_V(8); PG8_WAIT_L(0); PG8_BAR; PG8_MMA(0, 0, At, B0); PG8_MMA(0, 1, At, B1); PG8_BAR; PG8_SCHED;
            PG8_LDA(At, 0, 1); PG8_STAGE(PG8_SB(0, 0), b2, voffB); PG8_STAGE(PG8_SB(0, 1), b2 + hstep, voffB); PG8_STAGE(PG8_SA(0, 0), a2, voffA);
            PG8_WAIT_V(8); PG8_WAIT_L(0); PG8_BAR; PG8_MMA(1, 0, At, B0); PG8_MMA(1, 1, At, B1); PG8_BAR; PG8_SCHED;
            PG8_LDB(B0, 1, 0); PG8_LDB(B1, 1, 1); PG8_SCHED; PG8_LDA(At, 1, 0); PG8_STAGE(PG8_SA(0, 1), a2 + hstep, voffA);
            PG8_WAIT_V(8); PG8_WAIT_L(0); PG8_BAR; PG8_MMA(0, 0, At, B0); PG8_MMA(0, 1, At, B1); PG8_BAR; PG8_SCHED;
            PG8_LDA(At, 1, 1); PG8_STAGE(PG8_SB(1, 0), b3, voffB); PG8_STAGE(PG8_SB(1, 1), b3 + hstep, voffB); PG8_STAGE(PG8_SA(1, 0), a3, voffA);
            PG8_WAIT_V(8); PG8_WAIT_L(0); PG8_BAR; PG8_MMA(1, 0, At, B0); PG8_MMA(1, 1, At, B1); PG8_BAR; PG8_SCHED;
            } else {
            PG8_LDB(B0, 0, 0); PG8_SCHED; PG8_LDA(At, 0, 0); PG8_STAGE(PG8_SA(1, 1), a1 + hstep, voffA);
            PG8_WAIT_L(8); PG8_BAR; PG8_WAIT_L(0); PG8_MMA(0, 0, At, B0); PG8_BAR; PG8_SCHED;
            PG8_LDB(B1, 0, 1); PG8_STAGE(PG8_SB(0, 0), b2, voffB);
            PG8_BAR; PG8_WAIT_L(0); PG8_MMA(0, 1, At, B1); PG8_BAR;
            PG8_LDA(At, 0, 1); PG8_STAGE(PG8_SA(0, 0), a2, voffA);
            PG8_BAR; PG8_WAIT_L(0); PG8_MMA(1, 0, At, B0); PG8_BAR; PG8_SCHED;
            PG8_STAGE(PG8_SB(0, 1), b2 + hstep, voffB);
            PG8_WAIT_V(6); PG8_BAR; PG8_MMA(1, 1, At, B1); PG8_BAR;
            PG8_LDB(B0, 1, 0); PG8_SCHED; PG8_LDA(At, 1, 0); PG8_STAGE(PG8_SA(0, 1), a2 + hstep, voffA);
            PG8_WAIT_L(8); PG8_BAR; PG8_WAIT_L(0); PG8_MMA(0, 0, At, B0); PG8_BAR; PG8_SCHED;
            PG8_LDB(B1, 1, 1); PG8_STAGE(PG8_SB(1, 0), b3, voffB);
            PG8_BAR; PG8_WAIT_L(0); PG8_MMA(0, 1, At, B1); PG8_BAR;
            PG8_LDA(At, 1, 1); PG8_STAGE(PG8_SA(1, 0), a3, voffA);
            PG8_BAR; PG8_WAIT_L(0); PG8_MMA(1, 0, At, B0); PG8_BAR; PG8_SCHED;
            PG8_STAGE(PG8_SB(1, 1), b3 + hstep, voffB);
            PG8_WAIT_V(6); PG8_BAR; PG8_MMA(1, 1, At, B1); PG8_BAR;
            }
        }
        if constexpr (ALIGN_EPI) { if (wr == 0) PG8_BAR; }
        if constexpr (!Epi::AFTER_DRAIN) { E(acc, cur, wr, wc, fr, fq); S.done(cur); }
        if (!has_next) break;
#pragma unroll
        for (int a = 0; a < 2; ++a)
#pragma unroll
            for (int b = 0; b < 2; ++b)
#pragma unroll
                for (int m = 0; m < 4; ++m)
#pragma unroll
                    for (int n = 0; n < 2; ++n) acc[a][b][m][n] = (f32x4){0.f, 0.f, 0.f, 0.f};
        cur = nxt; cA = nA; cB = nB; ++ui;
        if constexpr (ALIGN_EPI) { if (wr == 1) PG8_BAR; }
    }
    PG8_WAIT_V(0);
    if constexpr (!ALIGN_EPI) { if (wr == 0) PG8_BAR; }
    PG8_BAR;
    if constexpr (Epi::AFTER_DRAIN) { E.fused(acc, cur, wr, wc, fr, fq, lds, wid, lane); S.done(cur); }
#undef PG8_SA
#undef PG8_SB
#undef PG8_STAGE
#undef PG8_LDA
#undef PG8_LDB
#undef PG8_MMA
#undef PG8_WAIT_V
#undef PG8_WAIT_L
#undef PG8_BAR
#undef PG8_SCHED
}
}
#ifndef PG8_SP2
#define PG8_SP2 true
#endif
#ifndef PG8_ALIGN
#define PG8_ALIGN true
#endif
#ifndef RPT_AC
#define RPT_AC 1
#endif
#ifndef RPT_GEMM
#define RPT_GEMM 1
#endif
#ifndef RPT_B3
#define RPT_B3 1
#endif
#ifndef MK_PER_PHASE
#define MK_PER_PHASE 0
#endif

constexpr int DM = 2048, MT = 32768, NIN = 5120, DFF = 5632, NGU = 2 * DFF, NL = 2;
constexpr int C_QA = 0, C_KA = 768, C_VA = 1536, C_QR = 2304, C_KR = 2560, C_VR = 2816, C_GR = 3328, C_QC = 3840, C_KC = 4608, C_VC = 4864;
constexpr int MX_A = 0, MX_R = 768, MX_C = 1280;
constexpr int NWAVES = 8, NTHR = 512;
constexpr float LOG2E = 1.4426950408889634f;
constexpr size_t MiB = 1u << 20;
constexpr size_t WS_LUTA = 1 * MiB, WS_LUTC = 1 * MiB + 32768, WS_PAR = 1 * MiB + 65536, WS_CS = 2 * MiB;
constexpr size_t WS_W = 4 * MiB, W_IN = 0, W_OUT = 20 * MiB, W_GU = 28 * MiB, W_DN = 72 * MiB, W_LAYER = 94 * MiB;
constexpr size_t WS_XB = 192 * MiB, WS_PROJ = 320 * MiB, WS_MIX = 640 * MiB, WS_H = WS_PROJ, WS_PART = 768 * MiB, WS_KVF = 772 * MiB, WS_KVB = 788 * MiB, WS_END = 804 * MiB;
static_assert(WS_W + NL * W_LAYER <= WS_XB && (size_t)MT * DFF * 2 <= WS_PART - WS_H, "ws map");
constexpr int RING_BYTES = 131072, LDS_BYTES = 147456;
constexpr int WLDS = 16384;

#define LAS __attribute__((address_space(3)))
typedef unsigned short bf16_t;
typedef unsigned u32x4 __attribute__((ext_vector_type(4)));
typedef unsigned u32x2 __attribute__((ext_vector_type(2)));
typedef float f32x4 __attribute__((ext_vector_type(4)));
typedef float f32x2 __attribute__((ext_vector_type(2)));
typedef short bf16x8 __attribute__((ext_vector_type(8)));
typedef short s16x4 __attribute__((ext_vector_type(4)));
__device__ __forceinline__ float bf2f(unsigned short v) { return __uint_as_float((unsigned)v << 16); }
__device__ __forceinline__ unsigned pk2(float lo, float hi) { return pg8::cvt_pk_bf16(lo, hi); }
__device__ __forceinline__ float ex2(float x) { return __builtin_amdgcn_exp2f(x); }
__device__ __forceinline__ float wave_sum(float v, int lane) {
#pragma unroll
    for (int o = 1; o < 64; o <<= 1) v += shx(v, o, lane);
    return v;
}
__device__ __forceinline__ s16x4 tr16(const LAS unsigned char* p) { return __builtin_bit_cast(s16x4, __builtin_amdgcn_ds_read_tr16_b64_v4i16((LAS s16x4*)p)); }
#define MFMA16(a, b, c) __builtin_amdgcn_mfma_f32_16x16x32_bf16(a, b, c, 0, 0, 0)

__constant__ double ROPE_FR[16] = {0.15915494309189535, 0.08949940160889101, 0.050329212104487035, 0.0283021958306234, 0.015915494309189534, 0.008949940160889102, 0.005032921210448704, 0.00283021958306234,
    0.0015915494309189536, 0.0008949940160889102, 0.0005032921210448703, 0.00028302195830623395, 0.00015915494309189535, 8.949940160889102e-05, 5.0329212104487035e-05, 2.8302195830623396e-05};

#define RLX_AGENT __ATOMIC_RELAXED, __HIP_MEMORY_SCOPE_AGENT
#define XB_TMO      128
#define XB_XCNT(j)  (256  + 64 * (j))
#define XB_XSUB(j)  (1280 + 64 * (j))
#define XB_XGEN(j)  (2304 + 64 * (j))
#define XB_TOP      3328
#define XB_TOPGEN   3392
#define XCD_BAR_WORDS 3456
#define XB_SPIN_CAP (1u << 18)

__device__ __forceinline__ unsigned xb_ld(unsigned* p)              { return __hip_atomic_load(p, __ATOMIC_RELAXED, __HIP_MEMORY_SCOPE_AGENT); }
__device__ __forceinline__ unsigned xb_add(unsigned* p, unsigned v) { return __hip_atomic_fetch_add(p, v, __ATOMIC_RELAXED, __HIP_MEMORY_SCOPE_AGENT); }
__device__ __forceinline__ unsigned xb_xcc_id() { return (unsigned)__builtin_amdgcn_s_getreg((3 << 11) | 20) & 0xFu; }
#define XB_SPIN(cond, bar) do { unsigned _sp = 0; while (cond) { __builtin_amdgcn_s_sleep(1); \
    if ((++_sp & 255u) == 0u) { if (xb_ld(&(bar)[XB_TMO])) break; if (_sp > XB_SPIN_CAP) { atomicAdd(&(bar)[XB_TMO], 1u); break; } } } } while (0)

struct XcdBarrier {
    unsigned* bar; unsigned x;
    volatile LAS unsigned* st;
};

__device__ __forceinline__ XcdBarrier xcd_barrier_post(unsigned* bar, volatile LAS unsigned* st, bool is_t0) {
    XcdBarrier b; b.bar = bar; b.x = xb_xcc_id(); b.st = st;
    if (is_t0) (void)xb_add(&bar[XB_XCNT(b.x)], 1u);
    return b;
}
__device__ __forceinline__ void xcd_barrier_complete(unsigned* bar, unsigned x, unsigned& nloc, unsigned& nx) {
    const unsigned G = gridDim.x * gridDim.y * gridDim.z;
    unsigned sum, cnt, mine, sp = 0u;
    for (;;) {
        sum = 0u; cnt = 0u; mine = 0u;
#pragma unroll
        for (unsigned j = 0; j < 16; ++j) { const unsigned c = xb_ld(&bar[XB_XCNT(j)]); sum += c; cnt += (c > 0u) ? 1u : 0u; mine = (j == x) ? c : mine; }
        if (sum == G) break;
        __builtin_amdgcn_s_sleep(1);
        if ((++sp & 255u) == 0u) { if (xb_ld(&bar[XB_TMO])) break; if (sp > XB_SPIN_CAP) { atomicAdd(&bar[XB_TMO], 1u); break; } }
    }
    nloc = mine > 0u ? mine : 1u; nx = cnt > 0u ? cnt : 1u;
}

__device__ __forceinline__ void xcd_barrier(const XcdBarrier& b, bool is_t0) {
    asm volatile("s_waitcnt vmcnt(0)" ::: "memory");
    __syncthreads();
    if (is_t0) {
        unsigned* bar = b.bar;
        __builtin_amdgcn_s_waitcnt(0);
        unsigned nloc = b.st[0], nx = b.st[1];
        if (nloc == 0u) { xcd_barrier_complete(bar, b.x, nloc, nx); b.st[0] = nloc; b.st[1] = nx; }
        const unsigned old = xb_add(&bar[XB_XSUB(b.x)], 1u);
        const unsigned gen = old / nloc;
        if (old + 1u == (gen + 1u) * nloc) {
            __builtin_amdgcn_fence(__ATOMIC_RELEASE, "agent");
            asm volatile("s_waitcnt vmcnt(0)" ::: "memory");
            const unsigned og = xb_add(&bar[XB_TOP], 1u);
            const unsigned tg = og / nx;
            if (og + 1u == (tg + 1u) * nx) xb_add(&bar[XB_TOPGEN], 1u);
            else XB_SPIN(xb_ld(&bar[XB_TOPGEN]) == tg, bar);
            __builtin_amdgcn_fence(__ATOMIC_ACQUIRE, "agent");
            xb_add(&bar[XB_XGEN(b.x)], 1u);
            asm volatile("s_waitcnt vmcnt(0)" ::: "memory");
        } else {
            XB_SPIN(xb_ld(&bar[XB_XGEN(b.x)]) == gen, bar);
            __builtin_amdgcn_fence(__ATOMIC_ACQUIRE, "agent");
            asm volatile("s_waitcnt vmcnt(0)" ::: "memory");
        }
    }
    __syncthreads();
}

struct Trunk { const float* x; float* out; int nseq, S; };
struct Frame {
    LAS unsigned char* lds; int tid, lane, wave, G, bx, gw, NGW;
    unsigned char* ws;
};

struct TrItem { const float* W; const float* gain; bf16_t* WT; int K, N, k0, n0, drow0; };
__device__ __forceinline__ void tr_load(const TrItem& t, int lane, float (&wv)[32]) {
#pragma unroll
    for (int i = 0; i < 32; ++i) wv[i] = t.W[(size_t)(t.k0 + 2 * i + (lane >> 5)) * t.N + t.n0 + (lane & 31)];
}
__device__ __forceinline__ void tr_store(const TrItem& t, LAS float* scr, int lane, float (&wv)[32]) {
    if (t.gain) {
#pragma unroll
        for (int i = 0; i < 32; ++i) wv[i] *= t.gain[t.k0 + 2 * i + (lane >> 5)]; }
#pragma unroll
    for (int i = 0; i < 32; ++i) scr[(2 * i + (lane >> 5)) * 33 + (lane & 31)] = wv[i];
    asm volatile("s_waitcnt lgkmcnt(0)" ::: "memory");
    const int c = lane & 7;
#pragma unroll
    for (int j = 0; j < 4; ++j) { const int n = (lane >> 3) + 8 * j; const LAS float* s = scr + (8 * c) * 33 + n;
        u32x4 o; o.x = pk2(s[0 * 33], s[1 * 33]); o.y = pk2(s[2 * 33], s[3 * 33]); o.z = pk2(s[4 * 33], s[5 * 33]); o.w = pk2(s[6 * 33], s[7 * 33]);
        *(u32x4*)(t.WT + (size_t)(t.drow0 + n) * t.K + t.k0 + 8 * c) = o; }
    asm volatile("s_waitcnt lgkmcnt(0)" ::: "memory");
}
__device__ __forceinline__ int t5_bucket(int rel) {
    const int n = rel < 0 ? -rel : rel;
    const int b = n < 8 ? n : 8 + (n >= 15) + (n >= 27) + (n >= 50) + (n >= 91) + (n >= 166) + (n >= 305) + (n >= 559);
    return (rel > 0 ? 16 : 0) + b;
}
__device__ __forceinline__ float decay_lg2(float a) {
    const float x = ex2(-a);
    if (x > 0.1f) return __log2f(1.0f - x);
    const float s = x * (1.f + x * (0.5f + x * (1.f / 3 + x * (0.25f + x * (0.2f + x * (1.f / 6 + x * (1.f / 7)))))));
    return -s * LOG2E;
}
__device__ __forceinline__ void weights_prologue(Frame& F, const float* const (&in)[14]) {
    LAS float* scr = (LAS float*)(F.lds + F.wave * WLDS);
    constexpr int I_IN = 32 * 160, I_OUT = 32 * 64, I_G = 32 * 176, I_D = 88 * 64, I_LAYER = I_IN + I_OUT + 2 * I_G + I_D;
    auto decode = [&](int it, TrItem& t) {
        const int l = it / I_LAYER; int r = it % I_LAYER; unsigned char* wl = F.ws + WS_W + (size_t)l * W_LAYER;
        if (r < I_IN) { const int kb = r / 160, nb = r % 160; t = TrItem{in[4] + (size_t)l * DM * NIN, in[3] + l * DM, (bf16_t*)(wl + W_IN), DM, NIN, 64 * kb, 32 * nb, 32 * nb}; return; } r -= I_IN;
        if (r < I_OUT) { const int kb = r / 64, nb = r % 64; t = TrItem{in[8] + (size_t)l * DM * DM, nullptr, (bf16_t*)(wl + W_OUT), DM, DM, 64 * kb, 32 * nb, 32 * nb}; return; } r -= I_OUT;
        if (r < 2 * I_G) { const int up = r >= I_G; if (up) r -= I_G; const int kb = r / 176, nb = r % 176; const int n0 = 32 * nb;
            t = TrItem{in[up ? 11 : 10] + (size_t)l * DM * DFF, in[9] + l * DM, (bf16_t*)(wl + W_GU), DM, DFF, 64 * kb, n0, (n0 >> 7) * 256 + (n0 & 127) + (up ? 128 : 0)}; return; } r -= 2 * I_G;
        { const int kb = r / 64, nb = r % 64; t = TrItem{in[12] + (size_t)l * DFF * DM, nullptr, (bf16_t*)(wl + W_DN), DFF, DM, 64 * kb, 32 * nb, 32 * nb}; }
    };
    {
        TrItem tc, tn; float wa[32], wb[32]; int it = F.gw;
        if (it < NL * I_LAYER) { decode(it, tc); tr_load(tc, F.lane, wa); }
        while (it < NL * I_LAYER) {
            const int itn = it + F.NGW; const bool more = itn < NL * I_LAYER;
            if (more) { decode(itn, tn); tr_load(tn, F.lane, wb); }
            tr_store(tc, scr, F.lane, wa);
            if (!more) break;
            const int itn2 = itn + F.NGW; const bool more2 = itn2 < NL * I_LAYER;
            if (more2) { decode(itn2, tc); tr_load(tc, F.lane, wa); }
            tr_store(tn, scr, F.lane, wb);
            if (!more2) break;
            it = itn2;
        }
    }
    const int gt = F.bx * NTHR + F.tid, NGT = F.G * NTHR;
    const float* rb = in[2];
    float* lutA = (float*)(F.ws + WS_LUTA); float* lutC = (float*)(F.ws + WS_LUTC);
    for (int i = gt; i < 12 * 387 + 12 * 257; i += NGT) {
        if (i < 12 * 387) { const int h = i / 387, r = i % 387, br = r / 129, mm = r % 129 - 64; const int dil = br == 0 ? 1 : (br == 1 ? 4 : 16);
            lutA[i] = rb[t5_bucket(mm * dil) * 24 + h] * LOG2E; }
        else { const int j = i - 12 * 387, h = j / 257, off = j % 257 - 128; lutC[j] = rb[t5_bucket(off) * 24 + 12 + h] * LOG2E; }
    }
    float* par = (float*)(F.ws + WS_PAR);
    for (int i = gt; i < 64 + 2048; i += NGT) {
        if (i < 16) par[i] = decay_lg2(in[5][i]);
        else if (i < 32) par[i] = decay_lg2(in[6][i - 16]);
        else if (i < 56) par[i] = in[7][i - 32] * LOG2E;
        else if (i >= 64) par[i] = in[13][i - 64];
    }
    f32x2* cs = (f32x2*)(F.ws + WS_CS);
    for (int i = gt; i < 16384 * 16; i += NGT) { const int pos = i >> 4, j = i & 15; double rev = (double)pos * ROPE_FR[j]; rev -= __builtin_rint(rev); const float r = (float)rev;
        cs[i] = (f32x2){__builtin_amdgcn_cosf(r), __builtin_amdgcn_sinf(r)}; }
}
__device__ __forceinline__ void trunk_prologue(Frame& F, const Trunk& T) {
    bf16_t* xb = (bf16_t*)(F.ws + WS_XB); float* part = (float*)(F.ws + WS_PART);
    for (int row = F.gw; row < MT; row += 2 * F.NGW) {
        const int row2 = row + F.NGW;
        const f32x4* xr = (const f32x4*)(T.x + (size_t)row * DM) + F.lane; const f32x4* xr2 = (const f32x4*)(T.x + (size_t)row2 * DM) + F.lane; f32x4 v1[8], v2[8];
#pragma unroll
        for (int j = 0; j < 8; ++j) { v1[j] = xr[64 * j]; v2[j] = xr2[64 * j]; }
#pragma unroll
        for (int rr = 0; rr < 2; ++rr) { float s = 0.f; const int r = rr ? row2 : row;
            u32x2* o = (u32x2*)(xb + (size_t)r * DM) + F.lane;
#pragma unroll
            for (int j = 0; j < 8; ++j) { const f32x4 v = rr ? v2[j] : v1[j]; s += (v[0] * v[0] + v[1] * v[1]) + (v[2] * v[2] + v[3] * v[3]);
                u32x2 w; w.x = pk2(v[0], v[1]); w.y = pk2(v[2], v[3]); o[64 * j] = w; }
            s = wave_sum(s, F.lane);
            if (F.lane < 32) part[(size_t)F.lane * MT + r] = F.lane == 0 ? s : 0.f; }
    }
}
__device__ __forceinline__ void final_norm(Frame& F, const Trunk& T) {
    const f32x4* g4 = (const f32x4*)((const float*)(F.ws + WS_PAR) + 64) + F.lane; const bf16_t* xb = (const bf16_t*)(F.ws + WS_XB);
    for (int row = F.gw; row < MT; row += 4 * F.NGW) {
        u32x2 bq[4][8];
#pragma unroll
        for (int rr = 0; rr < 4; ++rr) { const u32x2* xr = (const u32x2*)(xb + (size_t)(row + rr * F.NGW) * DM) + F.lane;
#pragma unroll
            for (int j = 0; j < 8; ++j) bq[rr][j] = xr[64 * j]; }
#pragma unroll
        for (int rr = 0; rr < 4; ++rr) { f32x4 v[8]; float s = 0.f;
#pragma unroll
            for (int j = 0; j < 8; ++j) { const u32x2 b = bq[rr][j]; v[j] = (f32x4){__uint_as_float(b.x << 16), __uint_as_float(b.x & 0xffff0000u), __uint_as_float(b.y << 16), __uint_as_float(b.y & 0xffff0000u)};
                s += (v[j][0] * v[j][0] + v[j][1] * v[j][1]) + (v[j][2] * v[j][2] + v[j][3] * v[j][3]); }
            const float rs = rsqrtf(wave_sum(s, F.lane) * (1.0f / DM) + 1e-6f);
            f32x4* yr = (f32x4*)(T.out + (size_t)(row + rr * F.NGW) * DM) + F.lane;
#pragma unroll
            for (int j = 0; j < 8; ++j) yr[64 * j] = v[j] * rs * g4[64 * j]; }
    }
}
constexpr int VPITCH = 144;
__device__ __forceinline__ void stage_v_regs(const u32x4 (&v)[4], LAS unsigned char* vimg, int lane, bf16x8 (&vf)[4]) {
    LAS unsigned char* d = vimg + (lane >> 3) * VPITCH + (lane & 7) * 16;
#pragma unroll
    for (int i = 0; i < 4; ++i) *(LAS u32x4*)(d + 8 * i * VPITCH) = v[i];
    asm volatile("" ::: "memory");
    const int i16 = lane & 15, quad = lane >> 4;
    const LAS unsigned char* b = vimg + (4 * quad + (i16 >> 2)) * VPITCH + (i16 & 3) * 8;
#pragma unroll
    for (int nn = 0; nn < 4; ++nn) { const s16x4 lo = tr16(b + nn * 32), hi = tr16(b + 16 * VPITCH + nn * 32); vf[nn] = (bf16x8){lo[0], lo[1], lo[2], lo[3], hi[0], hi[1], hi[2], hi[3]}; }
    asm volatile("" ::: "memory");
}
__device__ __forceinline__ void rope8(const bf16x8 x1, const bf16x8 x2, const f32x2* cs8, float sc, float (&y1)[8], float (&y2)[8]) {
    const f32x4* c4 = (const f32x4*)cs8; const f32x4 t0 = c4[0], t1 = c4[1], t2 = c4[2], t3 = c4[3];
    const float co[8] = {t0[0], t0[2], t1[0], t1[2], t2[0], t2[2], t3[0], t3[2]}, si[8] = {t0[1], t0[3], t1[1], t1[3], t2[1], t2[3], t3[1], t3[3]};
#pragma unroll
    for (int j = 0; j < 8; ++j) { const float a = bf2f((unsigned short)x1[j]), bb = bf2f((unsigned short)x2[j]); y1[j] = (a * co[j] - bb * si[j]) * sc; y2[j] = (a * si[j] + bb * co[j]) * sc; }
}
__device__ __forceinline__ u32x4 pack8(const float (&y)[8], float w) { u32x4 r; r.x = pk2(y[0] * w, y[1] * w); r.y = pk2(y[2] * w, y[3] * w); r.z = pk2(y[4] * w, y[5] * w); r.w = pk2(y[6] * w, y[7] * w); return r; }
constexpr int KPITCH = 80;
__device__ __forceinline__ void ret_chunk_states(Frame& F, const Trunk& T, int layer) {
    bf16_t* proj = (bf16_t*)(F.ws + WS_PROJ); const f32x2* cs = (const f32x2*)(F.ws + WS_CS);
    float* kvf = (float*)(F.ws + WS_KVF); float* kvb = (float*)(F.ws + WS_KVB);
    LAS unsigned char* vimg = F.lds + F.wave * WLDS; LAS unsigned char* kfimg = vimg + 32 * VPITCH; LAS unsigned char* kbimg = kfimg + 32 * KPITCH;
    const int cps = T.S / 128, lane = F.lane, i16 = lane & 15, quad = lane >> 4; const f32x4 z4 = {0.f, 0.f, 0.f, 0.f};
    for (int it = F.gw; it < 256 * 8; it += F.NGW) {
        const int gch = it >> 3, h = it & 7, b = gch / cps, c = gch % cps, pos0 = c * 128; const size_t row0 = (size_t)b * T.S + pos0;
        const float* par = (const float*)(F.ws + WS_PAR); const float lgf = par[layer * 8 + h], lgb = par[16 + layer * 8 + h];
        { bf16x8 xa[4], xc[4]; f32x4 cq[4][4];
#pragma unroll
          for (int q4 = 0; q4 < 4; ++q4) { const int idx = q4 * 64 + lane, row = idx >> 1, cc = idx & 1;
              const bf16_t* p = proj + (row0 + row) * NIN + C_QR + h * 32 + 8 * cc; xa[q4] = *(const bf16x8*)p; xc[q4] = *(const bf16x8*)(p + 16);
              const f32x4* c4 = (const f32x4*)(cs + (size_t)(pos0 + row) * 16 + 8 * cc); cq[q4][0] = c4[0]; cq[q4][1] = c4[1]; cq[q4][2] = c4[2]; cq[q4][3] = c4[3]; }
          asm volatile("" ::: "memory");
#pragma unroll
          for (int q4 = 0; q4 < 4; ++q4) { const int idx = q4 * 64 + lane, row = idx >> 1, cc = idx & 1;
              bf16_t* p = proj + (row0 + row) * NIN + C_QR + h * 32 + 8 * cc;
              const f32x4 t0 = cq[q4][0], t1 = cq[q4][1], t2 = cq[q4][2], t3 = cq[q4][3];
              const float co[8] = {t0[0], t0[2], t1[0], t1[2], t2[0], t2[2], t3[0], t3[2]}, si[8] = {t0[1], t0[3], t1[1], t1[3], t2[1], t2[3], t3[1], t3[3]};
              float y1[8], y2[8];
#pragma unroll
              for (int j = 0; j < 8; ++j) { const float a = bf2f((unsigned short)xa[q4][j]), bb = bf2f((unsigned short)xc[q4][j]); y1[j] = a * co[j] - bb * si[j]; y2[j] = a * si[j] + bb * co[j]; }
              *(u32x4*)p = pack8(y1, 1.0f); *(u32x4*)(p + 16) = pack8(y2, 1.0f); } }
        f32x4 af[4][2], ab[4][2];
#pragma unroll
        for (int nn = 0; nn < 4; ++nn) { af[nn][0] = z4; af[nn][1] = z4; ab[nn][0] = z4; ab[nn][1] = z4; }
        const bf16_t* vp = proj + row0 * NIN + C_VR + h * 64;
#pragma unroll 1
        for (int t = 0; t < 4; ++t) {
            u32x4 vraw[4];
#pragma unroll
            for (int i = 0; i < 4; ++i) vraw[i] = *(const u32x4*)(vp + (size_t)(32 * t + 8 * i + (lane >> 3)) * NIN + (lane & 7) * 8);
            { const int row = lane >> 1, cc = lane & 1, sg = 32 * t + row;
                bf16_t* p = proj + (row0 + sg) * NIN + C_KR + h * 32 + 8 * cc;
                float y1[8], y2[8]; rope8(*(const bf16x8*)p, *(const bf16x8*)(p + 16), cs + (size_t)(pos0 + sg) * 16 + 8 * cc, 0.17677669529663687f, y1, y2);
                *(u32x4*)p = pack8(y1, 1.0f); *(u32x4*)(p + 16) = pack8(y2, 1.0f);
                const float wf = ex2(lgf * (float)(127 - sg)), wb = ex2(lgb * (float)sg);
                *(LAS u32x4*)(kfimg + row * KPITCH + 16 * cc) = pack8(y1, wf); *(LAS u32x4*)(kfimg + row * KPITCH + 32 + 16 * cc) = pack8(y2, wf);
                *(LAS u32x4*)(kbimg + row * KPITCH + 16 * cc) = pack8(y1, wb); *(LAS u32x4*)(kbimg + row * KPITCH + 32 + 16 * cc) = pack8(y2, wb); }
            bf16x8 vf[4]; stage_v_regs(vraw, vimg, lane, vf);
            bf16x8 kff[2], kbf[2];
            { const int ro = (4 * quad + (i16 >> 2)) * KPITCH + (i16 & 3) * 8;
#pragma unroll
                for (int nt = 0; nt < 2; ++nt) { const s16x4 l0 = tr16(kfimg + ro + nt * 32), h0 = tr16(kfimg + ro + 16 * KPITCH + nt * 32), l1 = tr16(kbimg + ro + nt * 32), h1 = tr16(kbimg + ro + 16 * KPITCH + nt * 32);
                    kff[nt] = (bf16x8){l0[0], l0[1], l0[2], l0[3], h0[0], h0[1], h0[2], h0[3]}; kbf[nt] = (bf16x8){l1[0], l1[1], l1[2], l1[3], h1[0], h1[1], h1[2], h1[3]}; } }
            asm volatile("" ::: "memory");
#pragma unroll
            for (int nn = 0; nn < 4; ++nn)
#pragma unroll
                for (int nt = 0; nt < 2; ++nt) { af[nn][nt] = MFMA16(vf[nn], kff[nt], af[nn][nt]); ab[nn][nt] = MFMA16(vf[nn], kbf[nt], ab[nn][nt]); }
        }
        float* of = kvf + (size_t)(gch * 8 + h) * 2048; float* ob = kvb + (size_t)(gch * 8 + h) * 2048;
#pragma unroll
        for (int nn = 0; nn < 4; ++nn)
#pragma unroll
            for (int nt = 0; nt < 2; ++nt)
#pragma unroll
                for (int j = 0; j < 4; ++j) { const int o = (16 * nn + 4 * quad + j) * 32 + 16 * nt + i16; of[o] = af[nn][nt][j]; ob[o] = ab[nn][nt][j]; }
    }
}
__device__ __forceinline__ void ret_scan(Frame& F, const Trunk& T, int layer) {
    const int n = T.S / 128, per_dir = T.nseq * 8 * 2048, gt = F.bx * NTHR + F.tid, NGT = F.G * NTHR;
    for (int idx = gt; idx < 2 * per_dir; idx += NGT) {
        const int dir = idx / per_dir, rem = idx % per_dir, b = rem / (8 * 2048), h = (rem >> 11) & 7, e = rem & 2047;
        const float g = ex2(128.f * ((const float*)(F.ws + WS_PAR))[dir * 16 + layer * 8 + h]);
        float* p = (float*)(F.ws + (dir ? WS_KVB : WS_KVF)) + ((size_t)(b * n) * 8 + h) * 2048 + e; const size_t cst = 8 * 2048;
        float R = 0.f;
        if (dir == 0) { for (int c0 = 0; c0 < n; c0 += 16) { float t[16];
#pragma unroll
                for (int u = 0; u < 16; ++u) t[u] = p[(size_t)(c0 + u) * cst];
#pragma unroll
                for (int u = 0; u < 16; ++u) { p[(size_t)(c0 + u) * cst] = R; R = R * g + t[u]; } } }
        else { for (int c0 = n - 16; c0 >= 0; c0 -= 16) { float t[16];
#pragma unroll
                for (int u = 0; u < 16; ++u) t[u] = p[(size_t)(c0 + u) * cst];
#pragma unroll
                for (int u = 15; u >= 0; --u) { p[(size_t)(c0 + u) * cst] = R; R = t[u] + g * R; } } }
    }
}
__device__ __forceinline__ void stage_v(const bf16_t* vrow  , LAS unsigned char* vimg, int lane, bf16x8 (&vf)[4]) {
    const u32x4* p = (const u32x4*)vrow; const u32x4 v0 = p[0], v1 = p[1], v2 = p[2], v3 = p[3];
    LAS u32x4* d = (LAS u32x4*)(vimg + (lane >> 1) * VPITCH + (lane & 1) * 64);
    d[0] = v0; d[1] = v1; d[2] = v2; d[3] = v3;
    asm volatile("" ::: "memory");
    const int i16 = lane & 15, quad = lane >> 4;
    const LAS unsigned char* b = vimg + (4 * quad + (i16 >> 2)) * VPITCH + (i16 & 3) * 8;
#pragma unroll
    for (int nn = 0; nn < 4; ++nn) { const s16x4 lo = tr16(b + nn * 32), hi = tr16(b + 16 * VPITCH + nn * 32); vf[nn] = (bf16x8){lo[0], lo[1], lo[2], lo[3], hi[0], hi[1], hi[2], hi[3]}; }
    asm volatile("" ::: "memory");
}
struct TileLdR { bf16x8 k[2]; u32x4 v[4]; };
__device__ __forceinline__ void tile_load_r(TileLdR& L, const bf16_t* kp  , const bf16_t* vp, int t, int lane) {
    const int i16 = lane & 15, quad = lane >> 4;
#pragma unroll
    for (int st = 0; st < 2; ++st) L.k[st] = *(const bf16x8*)(kp + (size_t)(32 * t + 16 * st + i16) * NIN + quad * 8);
#pragma unroll
    for (int i = 0; i < 4; ++i) L.v[i] = *(const u32x4*)(vp + (size_t)(32 * t + 8 * i + (lane >> 3)) * NIN + (lane & 7) * 8);
}
__device__ __forceinline__ void ret_output(Frame& F, const Trunk& T, int layer) {
    const bf16_t* proj = (const bf16_t*)(F.ws + WS_PROJ); bf16_t* mix = (bf16_t*)(F.ws + WS_MIX);
    const float* kvf = (const float*)(F.ws + WS_KVF); const float* kvb = (const float*)(F.ws + WS_KVB);
    LAS unsigned char* vimg = F.lds + F.wave * WLDS;
    const int cps = T.S / 128, lane = F.lane, i16 = lane & 15, quad = lane >> 4;
    const f32x4 z4 = {0.f, 0.f, 0.f, 0.f};
    for (int it = F.gw; it < 256 * 8; it += F.NGW) {
        const int gch = it >> 3, h = it & 7, b = gch / cps, c = gch % cps; const size_t row0 = (size_t)b * T.S + c * 128;
        const float* par = (const float*)(F.ws + WS_PAR); const float lgf = par[layer * 8 + h], lgb = par[16 + layer * 8 + h];
        const bf16_t* kp = proj + row0 * NIN + C_KR + h * 32; const bf16_t* vp = proj + row0 * NIN + C_VR + h * 64;
#pragma unroll 1
        for (int half = 0; half < 2; ++half) {
        TileLdR cur, nxt; tile_load_r(cur, kp, vp, 0, lane);
        bf16x8 qf[4];
#pragma unroll
        for (int qt = 0; qt < 4; ++qt) qf[qt] = *(const bf16x8*)(proj + (row0 + 64 * half + 16 * qt + i16) * NIN + C_QR + h * 32 + quad * 8);
        f32x4 o[4][4];
#pragma unroll
        for (int qt = 0; qt < 4; ++qt) { o[qt][0] = z4; o[qt][1] = z4; o[qt][2] = z4; o[qt][3] = z4; }
#pragma unroll 1
        for (int t = 0; t < 4; ++t) {
            if (t + 1 < 4) tile_load_r(nxt, kp, vp, t + 1, lane);
            bf16x8 vf[4]; stage_v_regs(cur.v, vimg, lane, vf);
            const int sg0 = 32 * t + 4 * quad - i16 - 64 * half;
#pragma unroll
            for (int qt = 0; qt < 4; ++qt) { float p[8];
#pragma unroll
                for (int st = 0; st < 2; ++st) { const f32x4 s = MFMA16(cur.k[st], qf[qt], z4);
#pragma unroll
                    for (int jj = 0; jj < 4; ++jj) { const int nd = sg0 + 16 * st + jj - 16 * qt;
                        const float w = nd <= 0 ? ex2(lgf * (float)(-nd)) : ex2(lgb * (float)nd); p[4 * st + jj] = s[jj] * w; } }
                const u32x4 pw = {pk2(p[0], p[1]), pk2(p[2], p[3]), pk2(p[4], p[5]), pk2(p[6], p[7])}; const bf16x8 pf = __builtin_bit_cast(bf16x8, pw);
#pragma unroll
                for (int nn = 0; nn < 4; ++nn) o[qt][nn] = MFMA16(vf[nn], pf, o[qt][nn]); }
            cur = nxt;
        }
        bf16x8 rf[4], rb[4];
#pragma unroll
        for (int nn = 0; nn < 4; ++nn) { const size_t oo = ((size_t)(gch * 8 + h) * 64 + 16 * nn + i16) * 32 + quad * 8;
            const f32x4 a0 = *(const f32x4*)(kvf + oo), a1 = *(const f32x4*)(kvf + oo + 4), b0 = *(const f32x4*)(kvb + oo), b1 = *(const f32x4*)(kvb + oo + 4);
            const u32x4 wa = {pk2(a0[0], a0[1]), pk2(a0[2], a0[3]), pk2(a1[0], a1[1]), pk2(a1[2], a1[3])}, wb = {pk2(b0[0], b0[1]), pk2(b0[2], b0[3]), pk2(b1[0], b1[1]), pk2(b1[2], b1[3])};
            rf[nn] = __builtin_bit_cast(bf16x8, wa); rb[nn] = __builtin_bit_cast(bf16x8, wb); }
#pragma unroll
        for (int qt = 0; qt < 4; ++qt) {
            const int tau = 64 * half + 16 * qt + i16; const size_t qrow = row0 + tau;
            const float wqf = ex2(lgf * (float)(tau + 1)), wqb = ex2(lgb * (float)(128 - tau));
            float s1 = 0.f;
#pragma unroll
            for (int nn = 0; nn < 4; ++nn) { const f32x4 xf = MFMA16(rf[nn], qf[qt], z4), xb = MFMA16(rb[nn], qf[qt], z4); o[qt][nn] = o[qt][nn] + xf * wqf + xb * wqb; s1 += (o[qt][nn][0] + o[qt][nn][1]) + (o[qt][nn][2] + o[qt][nn][3]); }
            s1 += shx(s1, 16, lane); s1 += shx(s1, 32, lane); const float mu = s1 * (1.f / 64.f); float s2 = 0.f;
#pragma unroll
            for (int nn = 0; nn < 4; ++nn) { o[qt][nn] = o[qt][nn] - mu; s2 += (o[qt][nn][0] * o[qt][nn][0] + o[qt][nn][1] * o[qt][nn][1]) + (o[qt][nn][2] * o[qt][nn][2] + o[qt][nn][3] * o[qt][nn][3]); }
            s2 += shx(s2, 16, lane); s2 += shx(s2, 32, lane); const float rs = rsqrtf(s2 * (1.f / 64.f) + 1e-5f);
#pragma unroll
            for (int nn = 0; nn < 4; ++nn) { const int col = h * 64 + 16 * nn + 4 * quad; const u32x2 gw = *(const u32x2*)(proj + qrow * NIN + C_GR + col);
                const float g0 = __uint_as_float(gw.x << 16), g1 = __uint_as_float(gw.x & 0xffff0000u), g2 = __uint_as_float(gw.y << 16), g3 = __uint_as_float(gw.y & 0xffff0000u);
                const f32x4 v = o[qt][nn] * rs; u32x2 w; w.x = pk2(pg8::silu_mul(g0, v[0]), pg8::silu_mul(g1, v[1])); w.y = pk2(pg8::silu_mul(g2, v[2]), pg8::silu_mul(g3, v[3]));
                *(u32x2*)(mix + qrow * DM + MX_R + col) = w; }
        }
        }
    }
}
struct TileLd { bf16x8 k[2][2]; u32x4 v[4]; };
template <bool EDGE>
__device__ __forceinline__ void tile_load(TileLd& L, const bf16_t* kp, const bf16_t* vp, int S, int pos0, int dil, int k0, int lane) {
    asm volatile("" : "+s"(k0), "+s"(pos0));
    const int i16 = lane & 15, quad = lane >> 4;
#pragma unroll
    for (int st = 0; st < 2; ++st) { int pos = pos0 + dil * (k0 + 16 * st + i16); if (EDGE) pos = min(max(pos, 0), S - 1);
        const bf16_t* p = kp + (long)pos * NIN + quad * 8; L.k[st][0] = *(const bf16x8*)p; L.k[st][1] = *(const bf16x8*)(p + 32); }
#pragma unroll
    for (int i = 0; i < 4; ++i) { int pos = pos0 + dil * (k0 + 8 * i + (lane >> 3)); if (EDGE) pos = min(max(pos, 0), S - 1);
        L.v[i] = *(const u32x4*)(vp + (long)pos * NIN + (lane & 7) * 8); }
}
template <int G, bool EDGE>
__device__ __forceinline__ void attn_tile(const TileLd& L, const int (&klo)[G], const int (&kspan)[G], int k0, int R, const int (&ua)[G], const LAS float* lut, int lutstride,
                                          LAS unsigned char* vimg, int lane, const bf16x8 (&q)[G][2], f32x4 (&o)[G][4], float (&m)[G], float (&l)[G]) {
    asm volatile("" : "+s"(k0));
    const int quad = lane >> 4; const f32x4 z4 = {0.f, 0.f, 0.f, 0.f};
    bf16x8 vf[4]; stage_v_regs(L.v, vimg, lane, vf);
    constexpr float C2 = 0.125f * LOG2E, THR = 6.0f;
    const int kb = k0 + 4 * quad;
#pragma unroll
    for (int g = 0; g < G; ++g) {
        const LAS float* lutb = lut + (kb - ua[g] + R);
        float sc[8]; float mx = -1e30f;
#pragma unroll
        for (int st = 0; st < 2; ++st) { f32x4 s = MFMA16(L.k[st][0], q[g][0], z4); s = MFMA16(L.k[st][1], q[g][1], s);
#pragma unroll
            for (int jj = 0; jj < 4; ++jj) { const int c = 16 * st + jj; const bool v = (unsigned)(kb - klo[g] + c) <= (unsigned)kspan[g];
                float x = s[jj] * C2 + lutb[g * lutstride + c]; x = v ? x : -1e30f; sc[4 * st + jj] = x; mx = fmaxf(mx, x); } }
        if (__any(mx - m[g] > THR)) {
            mx = fmaxf(mx, shx(mx, 16, lane)); mx = fmaxf(mx, shx(mx, 32, lane));
            const float mn = fmaxf(m[g], mx), al = ex2(m[g] - mn); m[g] = mn; l[g] *= al;
#pragma unroll
            for (int nn = 0; nn < 4; ++nn) o[g][nn] = o[g][nn] * al;
        }
        const float mn = m[g]; float p[8], ps = 0.f;
#pragma unroll
        for (int e = 0; e < 8; ++e) { p[e] = ex2(sc[e] - mn); ps += p[e]; }
        l[g] += ps;
        const u32x4 pw = {pg8::cvt_pk_vis(p[0], p[1]), pg8::cvt_pk_vis(p[2], p[3]), pg8::cvt_pk_vis(p[4], p[5]), pg8::cvt_pk_vis(p[6], p[7])}; const bf16x8 pf = __builtin_bit_cast(bf16x8, pw);
#pragma unroll
        for (int nn = 0; nn < 4; ++nn) o[g][nn] = MFMA16(vf[nn], pf, o[g][nn]);
    }
}
__device__ __forceinline__ void a_tile_params(int tt, int& br, int& dil, int& k0) {
    if (tt < 12) { br = 0; dil = 1; k0 = -64 + 32 * tt; } else if (tt < 18) { br = 1; dil = 4; k0 = -64 + 32 * (tt - 12); } else { br = 2; dil = 16; k0 = -64 + 32 * (tt - 18); }
}
template <bool EDGE>
__device__ __forceinline__ void mixer_a_item(const bf16_t* kp, const bf16_t* vp, int S, int pos0, const LAS float* lut, LAS unsigned char* vimg, int lane,
                                             const bf16x8 (&q)[1][2], f32x4 (&o)[1][4], float (&m)[1], float (&l)[1]) {
    const int i16 = lane & 15;
    TileLd ta, tb; tile_load<EDGE>(ta, kp, vp, S, pos0, 1, -64, lane);
#define A_STEP(CUR, NXT, TT, PF) do { int br_, dil_, k0_; a_tile_params((TT), br_, dil_, k0_); \
        if (PF) { int br1_, dil1_, k01_; a_tile_params((TT) + 1, br1_, dil1_, k01_); tile_load<EDGE>(NXT, kp, vp, S, pos0, dil1_, k01_, lane); } \
        const int ua_ = i16 * (16 / dil_); const int kmin_ = (dil_ == 1 ? -pos0 : (dil_ == 4 ? -(pos0 >> 2) : -(pos0 >> 4))), kmax_ = (dil_ == 1 ? S - 1 - pos0 : (dil_ == 4 ? (S - 1 - pos0) >> 2 : (S - 1 - pos0) >> 4)); \
        const int klo_ = max(ua_ - 64, kmin_), khi_ = min(ua_ + 64, kmax_); \
        const int kl1_[1] = {klo_}, ks1_[1] = {khi_ - klo_}, ua1_[1] = {ua_}; \
        attn_tile<1, EDGE>(CUR, kl1_, ks1_, k0_, 64, ua1_, lut + br_ * 129, 0, vimg, lane, q, o, m, l); } while (0)
#pragma unroll 1
    for (int tt = 0; tt < 22; tt += 2) { A_STEP(ta, tb, tt, true); A_STEP(tb, ta, tt + 1, true); }
    A_STEP(ta, tb, 22, false);
#undef A_STEP
}
__device__ __forceinline__ void mixer_a(Frame& F, const Trunk& T) {
    const bf16_t* proj = (const bf16_t*)(F.ws + WS_PROJ); bf16_t* mix = (bf16_t*)(F.ws + WS_MIX); const float* lutA = (const float*)(F.ws + WS_LUTA);
    LAS unsigned char* vimg = F.lds + F.wave * WLDS; LAS float* lut = (LAS float*)(vimg + 32 * VPITCH);
    const int lane = F.lane, i16 = lane & 15, quad = lane >> 4; const f32x4 z4 = {0.f, 0.f, 0.f, 0.f};
    const int NIT = (MT / 16) * 12, per = (NIT + F.NGW - 1) / F.NGW, bps = T.S / 256;
    const bool xmap = (F.G == 256);
    for (int j = 0; j < per; ++j) {
        int h, rest;
        if (xmap) { h = j; rest = ((F.bx & 7) * 16) * 16 + (F.bx >> 3) * NWAVES + F.wave; }
        else { const int it = (F.bx * per + j) * NWAVES + F.wave; if (it >= NIT) break; h = it / (MT / 16); rest = it % (MT / 16); }
        const int r = rest & 15, gblk = rest >> 4, b = gblk / bps, P0 = (gblk % bps) * 256;
        const size_t rowb = (size_t)b * T.S; const int posq = P0 + r + 16 * i16;
        const bf16_t* kp = proj + rowb * NIN + C_KA + h * 64; const bf16_t* vp = proj + rowb * NIN + C_VA + h * 64;
        bf16x8 q[1][2]; { const bf16_t* qp = proj + (rowb + posq) * NIN + C_QA + h * 64 + quad * 8; q[0][0] = *(const bf16x8*)qp; q[0][1] = *(const bf16x8*)(qp + 32); }
        for (int i = lane; i < 387; i += 64) lut[i] = lutA[h * 387 + i];
        asm volatile("s_waitcnt lgkmcnt(0)" ::: "memory");
        f32x4 o[1][4] = {{z4, z4, z4, z4}}; float m[1] = {-1e20f}, l[1] = {0.f};
        if (P0 >= 1024 && P0 + 1792 <= T.S) mixer_a_item<false>(kp, vp, T.S, P0 + r, lut, vimg, lane, q, o, m, l);
        else mixer_a_item<true>(kp, vp, T.S, P0 + r, lut, vimg, lane, q, o, m, l);
        float lt = l[0]; lt += shx(lt, 16, lane); lt += shx(lt, 32, lane); const float inv = 1.0f / lt;
#pragma unroll
        for (int nn = 0; nn < 4; ++nn) { const f32x4 v = o[0][nn] * inv; u32x2 w; w.x = pk2(v[0], v[1]); w.y = pk2(v[2], v[3]);
            *(u32x2*)(mix + (rowb + posq) * DM + MX_A + h * 64 + 16 * nn + 4 * quad) = w; }
    }
}
constexpr int A2_WL = 6400, A2_XO = 8 * A2_WL, A2_XP = 272, A2_XM = A2_XO + 256 * A2_XP, A2_XL = A2_XM + 1024;
static_assert(A2_XL + 1024 <= RING_BYTES, "mixer A exchange area inside the ring region");
template <bool EDGE>
__device__ __forceinline__ void a2_pass1(const bf16_t* kp, const bf16_t* vp, int S, int pos0, const LAS float* lut, LAS unsigned char* vimg, int lane,
                                         const bf16x8 (&q)[2][2], f32x4 (&o)[2][4], float (&m)[2], float (&l)[2]) {
    const int i16 = lane & 15;
    const int ua[2] = {i16, i16 + 16};
    const int klo[2] = {max(ua[0] - 64, -pos0), max(ua[1] - 64, -pos0)}, kspan[2] = {min(ua[0] + 64, S - 1 - pos0) - klo[0], min(ua[1] + 64, S - 1 - pos0) - klo[1]};
    TileLd ta, tb; tile_load<EDGE>(ta, kp, vp, S, pos0, 1, -64, lane);
#define P1_STEP(CUR, NXT, TT, PF) do { if (PF) tile_load<EDGE>(NXT, kp, vp, S, pos0, 1, -64 + 32 * ((TT) + 1), lane); \
        attn_tile<2, EDGE>(CUR, klo, kspan, -64 + 32 * (TT), 64, ua, lut, 0, vimg, lane, q, o, m, l); } while (0)
#pragma unroll 1
    for (int t = 0; t < 4; t += 2) { P1_STEP(ta, tb, t, true); P1_STEP(tb, ta, t + 1, true); }
    P1_STEP(ta, tb, 4, false);
#undef P1_STEP
}
template <bool EDGE>
__device__ __forceinline__ void a2_pass2(const bf16_t* kp, const bf16_t* vp, int S, int pos0, const LAS float* lut, LAS unsigned char* vimg, int lane,
                                         const bf16x8 (&q)[2][2], f32x4 (&o)[2][4], float (&m)[2], float (&l)[2]) {
    const int i16 = lane & 15;
    TileLd ta, tb; tile_load<EDGE>(ta, kp, vp, S, pos0, 4, -64, lane);
#define LDS_(NXT, s_) do { const int s__ = (s_); const int pb_ = s__ < 11 ? pos0 : pos0 + 8, dl_ = s__ < 6 ? 4 : 16, kk_ = -64 + 32 * (s__ < 6 ? s__ : (s__ < 11 ? s__ - 6 : s__ - 11)); \
        tile_load<EDGE>(NXT, kp, vp, S, pb_, dl_, kk_, lane); } while (0)
    {
        const int ua1[2] = {4 * i16, 4 * i16 + 2}; const int kmin1 = -(pos0 >> 2), kmax1 = (S - 1 - pos0) >> 2;
        const int klo1[2] = {max(ua1[0] - 64, kmin1), max(ua1[1] - 64, kmin1)}, ksp1[2] = {min(ua1[0] + 64, kmax1) - klo1[0], min(ua1[1] + 64, kmax1) - klo1[1]};
#define CP1(CUR, t_) attn_tile<2, EDGE>(CUR, klo1, ksp1, -64 + 32 * (t_), 64, ua1, lut + 129, 0, vimg, lane, q, o, m, l)
#pragma unroll 1
        for (int s_ = 0; s_ < 6; s_ += 2) { LDS_(tb, s_ + 1); CP1(ta, s_); LDS_(ta, s_ + 2); CP1(tb, s_ + 1); }
#undef CP1
    }
    const int ua2[1] = {i16};
    {
        const int klo2[1] = {max(i16 - 64, -(pos0 >> 4))}, ksp2[1] = {min(i16 + 64, (S - 1 - pos0) >> 4) - klo2[0]};
        const bf16x8 q1[1][2] = {{q[0][0], q[0][1]}}; f32x4 o1[1][4] = {{o[0][0], o[0][1], o[0][2], o[0][3]}}; float m1[1] = {m[0]}, l1[1] = {l[0]};
#define CP2(CUR, t_) attn_tile<1, EDGE>(CUR, klo2, ksp2, -64 + 32 * (t_), 64, ua2, lut + 258, 0, vimg, lane, q1, o1, m1, l1)
#pragma unroll 1
        for (int s_ = 6; s_ < 10; s_ += 2) { LDS_(tb, s_ + 1); CP2(ta, s_ - 6); LDS_(ta, s_ + 2); CP2(tb, s_ - 5); }
        LDS_(tb, 11); CP2(ta, 4);
#undef CP2
#pragma unroll
        for (int nn = 0; nn < 4; ++nn) o[0][nn] = o1[0][nn];
        m[0] = m1[0]; l[0] = l1[0];
    }
    {
        const int klo2[1] = {max(i16 - 64, -((pos0 + 8) >> 4))}, ksp2[1] = {min(i16 + 64, (S - 9 - pos0) >> 4) - klo2[0]};
        const bf16x8 q1[1][2] = {{q[1][0], q[1][1]}}; f32x4 o1[1][4] = {{o[1][0], o[1][1], o[1][2], o[1][3]}}; float m1[1] = {m[1]}, l1[1] = {l[1]};
#define CP2(CUR, t_) attn_tile<1, EDGE>(CUR, klo2, ksp2, -64 + 32 * (t_), 64, ua2, lut + 258, 0, vimg, lane, q1, o1, m1, l1)
#pragma unroll 1
        for (int s_ = 11; s_ < 15; s_ += 2) { LDS_(ta, s_ + 1); CP2(tb, s_ - 11); LDS_(tb, s_ + 2); CP2(ta, s_ - 10); }
        CP2(tb, 4);
#undef CP2
#pragma unroll
        for (int nn = 0; nn < 4; ++nn) o[1][nn] = o1[0][nn];
        m[1] = m1[0]; l[1] = l1[0];
    }
#undef LDS_
}
__device__ __forceinline__ void mixer_a2(Frame& F, const Trunk& T) {
    const bf16_t* proj = (const bf16_t*)(F.ws + WS_PROJ); bf16_t* mix = (bf16_t*)(F.ws + WS_MIX); const float* lutA = (const float*)(F.ws + WS_LUTA);
    LAS unsigned char* vimg = F.lds + F.wave * A2_WL; LAS float* lut = (LAS float*)(vimg + 32 * VPITCH);
    LAS unsigned char* XO = F.lds + A2_XO; LAS float* XM = (LAS float*)(F.lds + A2_XM); LAS float* XL = (LAS float*)(F.lds + A2_XL);
    const int lane = F.lane, i16 = lane & 15, quad = lane >> 4; const f32x4 z4 = {0.f, 0.f, 0.f, 0.f};
    const int bps = T.S / 256, lw = F.bx >> 3;
#pragma unroll 1
    for (int j = 0; j < 6; ++j) {
        const int h = 2 * j + (lw >> 4), gblk = (F.bx & 7) * 16 + (lw & 15), b = gblk / bps, P0 = (gblk % bps) * 256;
        const size_t rowb = (size_t)b * T.S;
        const bf16_t* kp = proj + rowb * NIN + C_KA + h * 64; const bf16_t* vp = proj + rowb * NIN + C_VA + h * 64;
        for (int i = lane; i < 387; i += 64) lut[i] = lutA[h * 387 + i];
        asm volatile("s_waitcnt lgkmcnt(0)" ::: "memory");
        {
            const int pos0 = P0 + 32 * F.wave;
            bf16x8 q[2][2]; f32x4 o[2][4]; float m[2], l[2];
#pragma unroll
            for (int g = 0; g < 2; ++g) { const bf16_t* qp = proj + (rowb + pos0 + 16 * g + i16) * NIN + C_QA + h * 64 + quad * 8; q[g][0] = *(const bf16x8*)qp; q[g][1] = *(const bf16x8*)(qp + 32);
                o[g][0] = z4; o[g][1] = z4; o[g][2] = z4; o[g][3] = z4; m[g] = -1e20f; l[g] = 0.f; }
            if (pos0 >= 64 && pos0 + 96 <= T.S) a2_pass1<false>(kp, vp, T.S, pos0, lut, vimg, lane, q, o, m, l);
            else a2_pass1<true>(kp, vp, T.S, pos0, lut, vimg, lane, q, o, m, l);
#pragma unroll
            for (int g = 0; g < 2; ++g) { float lt = l[g]; lt += shx(lt, 16, lane); lt += shx(lt, 32, lane);
                const int qi = 32 * F.wave + 16 * g + i16;
#pragma unroll
                for (int nn = 0; nn < 4; ++nn) *(LAS f32x4*)(XO + qi * A2_XP + (16 * nn + 4 * quad) * 4) = o[g][nn];
                if (quad == 0) { XM[qi] = m[g]; XL[qi] = lt; } }
        }
        __syncthreads();
        {
            const int pos0 = P0 + F.wave;
            bf16x8 q[2][2]; f32x4 o[2][4]; float m[2], l[2];
#pragma unroll
            for (int g = 0; g < 2; ++g) { const int qi = F.wave + 8 * g + 16 * i16;
                const bf16_t* qp = proj + (rowb + P0 + qi) * NIN + C_QA + h * 64 + quad * 8; q[g][0] = *(const bf16x8*)qp; q[g][1] = *(const bf16x8*)(qp + 32);
#pragma unroll
                for (int nn = 0; nn < 4; ++nn) o[g][nn] = *(const LAS f32x4*)(XO + qi * A2_XP + (16 * nn + 4 * quad) * 4);
                m[g] = XM[qi]; l[g] = quad == 0 ? XL[qi] : 0.f; }
            if (P0 >= 1024 && P0 + 1792 <= T.S) a2_pass2<false>(kp, vp, T.S, pos0, lut, vimg, lane, q, o, m, l);
            else a2_pass2<true>(kp, vp, T.S, pos0, lut, vimg, lane, q, o, m, l);
#pragma unroll
            for (int g = 0; g < 2; ++g) { float lt = l[g]; lt += shx(lt, 16, lane); lt += shx(lt, 32, lane); const float inv = 1.0f / lt;
                const size_t orow = rowb + P0 + F.wave + 8 * g + 16 * i16;
#pragma unroll
                for (int nn = 0; nn < 4; ++nn) { const f32x4 v = o[g][nn] * inv; u32x2 w; w.x = pk2(v[0], v[1]); w.y = pk2(v[2], v[3]);
                    *(u32x2*)(mix + orow * DM + MX_A + h * 64 + 16 * nn + 4 * quad) = w; } }
        }
        __syncthreads();
    }
}
template <bool EDGE>
__device__ __forceinline__ void mixer_c_item(const bf16_t* kp, const bf16_t* vp, int S, int P0, const LAS float* lut, LAS unsigned char* vimg, int lane,
                                             const bf16x8 (&q)[3][2], f32x4 (&o)[3][4], float (&m)[3], float (&l)[3]) {
    const int i16 = lane & 15;
    const int klo_1 = max(i16 - 128, -P0), kspan_1 = min(i16 + 128, S - 1 - P0) - klo_1; const int klo_c[3] = {klo_1, klo_1, klo_1}, kspan_c[3] = {kspan_1, kspan_1, kspan_1}, ua_c[3] = {i16, i16, i16};
    TileLd ta, tb; tile_load<EDGE>(ta, kp, vp, S, P0, 1, -128, lane);
#define C_STEP(CUR, NXT, TT, PF) do { if (PF) tile_load<EDGE>(NXT, kp, vp, S, P0, 1, -128 + 32 * ((TT) + 1), lane); \
        attn_tile<3, EDGE>(CUR, klo_c, kspan_c, -128 + 32 * (TT), 128, ua_c, lut, 257, vimg, lane, q, o, m, l); } while (0)
#pragma unroll 1
    for (int t = 0; t < 8; t += 2) { C_STEP(ta, tb, t, true); C_STEP(tb, ta, t + 1, true); }
    C_STEP(ta, tb, 8, false);
#undef C_STEP
}
__device__ __forceinline__ void mixer_c(Frame& F, const Trunk& T, int layer) {
    const bf16_t* proj = (const bf16_t*)(F.ws + WS_PROJ); bf16_t* mix = (bf16_t*)(F.ws + WS_MIX); const float* lutC = (const float*)(F.ws + WS_LUTC);
    LAS unsigned char* vimg = F.lds + F.wave * WLDS; LAS float* lut = (LAS float*)(vimg + 32 * VPITCH);
    const int lane = F.lane, i16 = lane & 15, quad = lane >> 4; const f32x4 z4 = {0.f, 0.f, 0.f, 0.f};
    const int NIT = (MT / 16) * 4, per = (NIT + F.NGW - 1) / F.NGW, bps = T.S / 16;
    const bool xmap = (F.G == 256);
    for (int j = 0; j < per; ++j) {
        int kvh, rest;
        if (xmap) { kvh = j; rest = (F.bx & 7) * 256 + (F.bx >> 3) * NWAVES + F.wave; }
        else { const int it = F.gw * per + j; if (it >= NIT) break; kvh = it / (MT / 16); rest = it % (MT / 16); }
        const int b = rest / bps, P0 = (rest % bps) * 16;
        const size_t rowb = (size_t)b * T.S; const int posq = P0 + i16;
        const bf16_t* kp = proj + rowb * NIN + C_KC + kvh * 64; const bf16_t* vp = proj + rowb * NIN + C_VC + kvh * 64;
        for (int i = lane; i < 771; i += 64) lut[i] = lutC[kvh * 771 + i];
        asm volatile("s_waitcnt lgkmcnt(0)" ::: "memory");
        bf16x8 q[3][2]; f32x4 o[3][4]; float m[3], l[3], snk[3];
#pragma unroll
        for (int g = 0; g < 3; ++g) { const bf16_t* qp = proj + (rowb + posq) * NIN + C_QC + (3 * kvh + g) * 64 + quad * 8; q[g][0] = *(const bf16x8*)qp; q[g][1] = *(const bf16x8*)(qp + 32);
            o[g][0] = z4; o[g][1] = z4; o[g][2] = z4; o[g][3] = z4; snk[g] = ((const float*)(F.ws + WS_PAR))[32 + layer * 12 + 3 * kvh + g]; m[g] = snk[g]; l[g] = 0.f; }
        if (P0 >= 128 && P0 + 160 <= T.S) mixer_c_item<false>(kp, vp, T.S, P0, lut, vimg, lane, q, o, m, l);
        else mixer_c_item<true>(kp, vp, T.S, P0, lut, vimg, lane, q, o, m, l);
#pragma unroll
        for (int g = 0; g < 3; ++g) { float lt = l[g]; lt += shx(lt, 16, lane); lt += shx(lt, 32, lane); lt += ex2(snk[g] - m[g]); const float inv = 1.0f / lt;
#pragma unroll
            for (int nn = 0; nn < 4; ++nn) { const f32x4 v = o[g][nn] * inv; u32x2 w; w.x = pk2(v[0], v[1]); w.y = pk2(v[2], v[3]);
                *(u32x2*)(mix + (rowb + posq) * DM + MX_C + (3 * kvh + g) * 64 + 16 * nn + 4 * quad) = w; } }
    }
}

struct Args { const float* in[14]; float* out; unsigned char* ws; int ph_lo, ph_hi; };
constexpr int NPHASES = 32;
__global__ void __launch_bounds__(NTHR, 2) mega_fwd(Args args) {
    extern __shared__ __attribute__((aligned(16))) unsigned char lds_raw[];
#define MKF Frame F; { int t_ = MYTID; asm volatile("" : "+v"(t_)); int b_ = blockIdx.x; asm volatile("" : "+s"(b_)); F.lds = (LAS unsigned char*)lds_raw; F.tid = t_; F.lane = t_ & 63; \
    F.wave = __builtin_amdgcn_readfirstlane(t_ >> 6); F.G = gridDim.x; F.bx = b_; F.gw = b_ * NWAVES + F.wave; F.NGW = F.G * NWAVES; { size_t z_ = 0; asm volatile("" : "+s"(z_)); F.ws = args.ws + z_; } }
#define MKT Trunk T; T.x = tr ? args.in[1] : args.in[0]; T.out = args.out + (size_t)tr * MT * DM; T.nseq = tr ? 2 : 4; T.S = tr ? 16384 : 8192;
#define OPQ size_t zo_ = 0; asm volatile("" : "+s"(zo_)); unsigned char* wsb_ = args.ws + zo_;
#define WSP(off) (wsb_ + (off))
    const int wave_s = __builtin_amdgcn_readfirstlane((int)threadIdx.x >> 6);
#define MYTID ({ unsigned z__ = 0u; asm volatile("" : "+s"(z__)); wave_s * 64 + (int)__builtin_amdgcn_mbcnt_hi(~0u, __builtin_amdgcn_mbcnt_lo(~0u, z__)); })
    const int lo = args.ph_lo, hi = args.ph_hi; int ph = 0;
#if !MK_PER_PHASE
    if (MYTID < 16) ((LAS unsigned*)(lds_raw + RING_BYTES))[MYTID] = 0u;
    __syncthreads();
    (void)xcd_barrier_post((unsigned*)args.ws, (volatile LAS unsigned*)((LAS unsigned char*)lds_raw + RING_BYTES), MYTID == 0);
#endif
#define XBAR do { XcdBarrier b_; b_.bar = (unsigned*)args.ws; b_.x = xb_xcc_id(); b_.st = (volatile LAS unsigned*)((LAS unsigned char*)lds_raw + RING_BYTES); xcd_barrier(b_, MYTID == 0); } while (0)
#define PH_ON (ph >= lo && ph < hi)
#if MK_PER_PHASE
#define PH_END do { ++ph; } while (0)
#else
#define PH_END do { if (ph >= lo && ph + 1 < hi) { if (ph == 0) cg::this_grid().sync(); else XBAR; } ++ph; } while (0)
#endif
    if (PH_ON) { MKF; const int tr = 0; MKT; weights_prologue(F, args.in); trunk_prologue(F, T); }
    PH_END;
#pragma unroll 1
    for (int tr = 0; tr < 2; ++tr) {
#pragma unroll 1
        for (int layer = 0; layer < NL; ++layer) {
            if (PH_ON) { OPQ; pg8::Gemm g{(const bf16_t*)WSP(WS_XB), (const bf16_t*)WSP(WS_W + (size_t)layer * W_LAYER + W_IN), MT, NIN, DM}; pg8::StaticOrder S; S.init(MT, NIN, gridDim.x, (int)blockIdx.x);
                pg8::EpiScaleBf16 E{(bf16_t*)WSP(WS_PROJ), NIN, (const float*)WSP(WS_PART), MT};
                for (int rp = 0; rp < RPT_GEMM; ++rp) pg8::gemm_phase<pg8::EpiScaleBf16, pg8::StaticOrder, PG8_ALIGN, PG8_SP2>((LAS unsigned char*)lds_raw, g, S, E, MYTID); }
            PH_END;
            if (PH_ON) { MKF; MKT; ret_chunk_states(F, T, layer); }
            PH_END;
            if (PH_ON) { MKF; MKT; ret_scan(F, T, layer); for (int rp = 0; rp < RPT_AC; ++rp) { if (F.G == 256) mixer_a2(F, T); else mixer_a(F, T); mixer_c(F, T, layer); } }
            PH_END;
            if (PH_ON) { MKF; MKT; for (int rp = 0; rp < RPT_B3; ++rp) ret_output(F, T, layer); }
            PH_END;
            if (PH_ON) { OPQ; pg8::Gemm g{(const bf16_t*)WSP(WS_MIX), (const bf16_t*)WSP(WS_W + (size_t)layer * W_LAYER + W_OUT), MT, DM, DM}; pg8::StaticOrder S; S.init(MT, DM, gridDim.x, (int)blockIdx.x);
                pg8::EpiResid E{(bf16_t*)WSP(WS_XB), (float*)WSP(WS_PART), MT};
                pg8::gemm_phase<pg8::EpiResid, pg8::StaticOrder, PG8_ALIGN, PG8_SP2>((LAS unsigned char*)lds_raw, g, S, E, MYTID); }
            PH_END;
            if (PH_ON) { OPQ; pg8::Gemm g{(const bf16_t*)WSP(WS_XB), (const bf16_t*)WSP(WS_W + (size_t)layer * W_LAYER + W_GU), MT, NGU, DM}; pg8::StaticOrder S; S.init(MT, NGU, gridDim.x, (int)blockIdx.x);
                pg8::EpiSwiGLU E{(bf16_t*)WSP(WS_H), DFF, (const float*)WSP(WS_PART), MT};
                for (int rp = 0; rp < RPT_GEMM; ++rp) pg8::gemm_phase<pg8::EpiSwiGLU, pg8::StaticOrder, PG8_ALIGN, PG8_SP2>((LAS unsigned char*)lds_raw, g, S, E, MYTID); }
            PH_END;
            if (PH_ON) { OPQ; pg8::Gemm g{(const bf16_t*)WSP(WS_H), (const bf16_t*)WSP(WS_W + (size_t)layer * W_LAYER + W_DN), MT, DM, DFF}; pg8::StaticOrder S; S.init(MT, DM, gridDim.x, (int)blockIdx.x);
                pg8::EpiResid E{(bf16_t*)WSP(WS_XB), (float*)WSP(WS_PART), MT};
                pg8::gemm_phase<pg8::EpiResid, pg8::StaticOrder, PG8_ALIGN, PG8_SP2>((LAS unsigned char*)lds_raw, g, S, E, MYTID); }
            PH_END;
        }
        if (PH_ON) { MKF; MKT; final_norm(F, T); }
        PH_END;
        if (tr == 0) { if (PH_ON) { MKF; Trunk T; T.x = args.in[1]; T.out = args.out + (size_t)MT * DM; T.nseq = 2; T.S = 16384; trunk_prologue(F, T); } PH_END; }
    }
}

extern "C" void kernel_launch(void* const* d_in, const int* in_sizes, int n_in, void* d_out, int out_size, void* d_ws, size_t ws_size, hipStream_t stream) {
    static int grid = 0;
    if (grid == 0) {
        if (n_in != 14 || in_sizes[0] != MT * DM || in_sizes[1] != MT * DM || out_size != 2 * MT * DM || ws_size < WS_END) {
            fprintf(stderr, "kernel_launch: unexpected shapes (n_in %d, in0 %d, out %d, ws %zu)\n", n_in, n_in > 0 ? in_sizes[0] : -1, out_size, ws_size); grid = -1; return; }
        int dev = 0, cus = 0, per_cu = 0;
        hipGetDevice(&dev); hipDeviceGetAttribute(&cus, hipDeviceAttributeMultiprocessorCount, dev);
        if (hipFuncSetAttribute((const void*)mega_fwd, hipFuncAttributeMaxDynamicSharedMemorySize, LDS_BYTES) != hipSuccess) { fprintf(stderr, "kernel_launch: hipFuncSetAttribute failed\n"); grid = -1; return; }
        if (hipOccupancyMaxActiveBlocksPerMultiprocessor(&per_cu, (const void*)mega_fwd, NTHR, LDS_BYTES) != hipSuccess || per_cu < 1) per_cu = 1;
        (void)hipGetLastError();
        grid = cus * per_cu;
    }
    if (grid < 0) return;
    Args a{};
    for (int i = 0; i < 14; ++i) a.in[i] = (const float*)d_in[i];
    a.out = (float*)d_out; a.ws = (unsigned char*)d_ws;
#if MK_PER_PHASE
    for (int p = 0; p < NPHASES; ++p) { a.ph_lo = p; a.ph_hi = p + 1; hipLaunchKernelGGL(mega_fwd, dim3(grid), dim3(NTHR), LDS_BYTES, stream, a); }
#else
    a.ph_lo = 0; a.ph_hi = NPHASES;
    if (hipMemsetAsync(d_ws, 0, 16384, stream) != hipSuccess) { fprintf(stderr, "kernel_launch: memset of the barrier words failed\n"); return; }
    void* params[] = {&a};
    hipError_t e = hipLaunchCooperativeKernel((const void*)mega_fwd, dim3(grid), dim3(NTHR), params, LDS_BYTES, stream);
    if (e != hipSuccess) fprintf(stderr, "kernel_launch: cooperative launch failed: %s (grid %d)\n", hipGetErrorString(e), grid);
#endif
}
```

```cpp
#include <hip/hip_runtime.h>
#include <hip/hip_cooperative_groups.h>
#include <cstdio>
#include <cstdint>
namespace cg = cooperative_groups;
__device__ __forceinline__ float shx(float v, int mask, int lane) { return __builtin_bit_cast(float, __builtin_amdgcn_ds_bpermute((lane ^ mask) << 2, __builtin_bit_cast(int, v))); }
namespace pg8 {
#define PG8_LAS __attribute__((address_space(3)))
typedef unsigned short bf16_t;
typedef short bf16x8 __attribute__((ext_vector_type(8)));
typedef float f32x4 __attribute__((ext_vector_type(4)));
typedef unsigned u32x4 __attribute__((ext_vector_type(4)));
constexpr int BM = 256, BK = 64, HALF = 128, HTB = HALF * BK * 2  , STAGE_BYTES = 8 * HTB, NXCD = 8, WGM = 8;

__host__ __device__ __forceinline__ int lds_byte(int r, int c) { const int st = (r >> 4) * 2 + (c >> 5), rr = r & 15, cc = c & 31, ob = rr * 64 + cc * 2; return st * 1024 + (ob ^ (((ob >> 9) & 1) << 5)); }
__host__ __device__ __forceinline__ void stage_rc(int b, int& R, int& C) { const int st = b / 1024, sb = b % 1024, swz = sb ^ (((sb >> 9) & 1) << 5); R = (st >> 1) * 16 + swz / 64; C = (st & 1) * 32 + (swz % 64) / 2; }
__host__ __device__ __forceinline__ int perm32(int rho) { const int n = rho >> 4, i = rho & 15; return 8 * (i >> 2) + 4 * n + (i & 3); }

struct Unit { int pm, pn; };
struct Gemm { const bf16_t* A; const bf16_t* Bt; int M, N, K; };

struct StaticOrder {
    int nM, nN, nwg, G, c;
    __host__ __device__ void init(int M, int N, int G_, int c_) { nM = M / BM; nN = N / BM; nwg = nM * nN; G = G_; c = c_; }
    __host__ __device__ bool next(int i, Unit& u) const {
        const long L = (long)i * G + c; if (L >= nwg) return false;
        int wgid = (int)L; { const int q = nwg / NXCD, r = nwg % NXCD, xcd = wgid % NXCD, off = wgid / NXCD; wgid = (xcd < r ? xcd * (q + 1) : r * (q + 1) + (xcd - r) * q) + off; }
        const int nig = WGM * nN, gid = wgid / nig, fm = gid * WGM, gsz = (nM - fm) < WGM ? (nM - fm) : WGM;
        u.pm = fm + ((wgid % nig) % gsz); u.pn = (wgid % nig) / gsz; return true;
    }
    __device__ __forceinline__ void a_ready(const Unit&) const {}
    __device__ __forceinline__ void done(const Unit&) const {}
};

__device__ __forceinline__ unsigned cvt_pk_bf16(float lo, float hi) { unsigned r; asm volatile("s_nop 0\n\tv_cvt_pk_bf16_f32 %0, %1, %2" : "=v"(r) : "v"(lo), "v"(hi)); return r; }
typedef __bf16 bf16x2_t __attribute__((ext_vector_type(2)));
typedef float f32x2_t __attribute__((ext_vector_type(2)));
__device__ __forceinline__ unsigned cvt_pk_vis(float lo, float hi) { const f32x2_t f = {lo, hi}; const bf16x2_t v = __builtin_convertvector(f, bf16x2_t); return __builtin_bit_cast(unsigned, v); }
typedef float f32x2 __attribute__((ext_vector_type(2)));
typedef unsigned u32x2 __attribute__((ext_vector_type(2)));
constexpr float RMS_EPS = 1e-6f;
__device__ __forceinline__ void rows_rstd(const float* part, int M, int row0, int fr, int fq, float (&rs)[8]) {
    const int L = fr | (fq << 4); const float* p = part + (row0 - fr) + L; float sa = 0.f, sb = 0.f;
#pragma unroll
    for (int i = 0; i < 32; ++i) { sa += p[(size_t)i * M]; sb += p[(size_t)i * M + HALF]; }
    const int ra = __builtin_bit_cast(int, rsqrtf(sa * (1.0f / 2048.0f) + RMS_EPS)), rb = __builtin_bit_cast(int, rsqrtf(sb * (1.0f / 2048.0f) + RMS_EPS));
#pragma unroll
    for (int r = 0; r < 8; ++r) rs[r] = __builtin_bit_cast(float, __builtin_amdgcn_ds_bpermute(((r & 3) * 16 + fr) << 2, (r >> 2) ? rb : ra));
}
struct EpiScaleBf16 {
    static constexpr bool PERM = true, AFTER_DRAIN = false;
    bf16_t* O; int ldc; const float* part; int M;
    __device__ __forceinline__ void operator()(const f32x4 (&acc)[2][2][4][2], const Unit& u, int wr, int wc, int fr, int fq) const {
        const int row0 = u.pm * BM + wr * 64 + fr; const int col0 = u.pn * BM + wc * 32 + 8 * fq;
        float rs8[8]; rows_rstd(part, M, row0, fr, fq, rs8);
#pragma unroll
        for (int ai = 0; ai < 2; ++ai)
#pragma unroll
            for (int m = 0; m < 4; ++m) { const int row = row0 + ai * HALF + m * 16; const float rs = rs8[ai * 4 + m];
                bf16_t* rowp = O + (size_t)row * ldc + col0;
#pragma unroll
                for (int bj = 0; bj < 2; ++bj) { const f32x4 v0 = acc[ai][bj][m][0] * rs, v1 = acc[ai][bj][m][1] * rs;
                    u32x4 w; w.x = cvt_pk_bf16(v0[0], v0[1]); w.y = cvt_pk_bf16(v0[2], v0[3]); w.z = cvt_pk_bf16(v1[0], v1[1]); w.w = cvt_pk_bf16(v1[2], v1[3]);
                    *(u32x4*)(rowp + bj * HALF) = w; } }
    }
};
__device__ __forceinline__ float silu_mul(float g, float u) { return g * u * __builtin_amdgcn_rcpf(1.0f + __expf(-g)); }
struct EpiSwiGLU {
    static constexpr bool PERM = true, AFTER_DRAIN = false;
    bf16_t* H; int ldh; const float* part; int M;
    __device__ __forceinline__ void operator()(const f32x4 (&acc)[2][2][4][2], const Unit& u, int wr, int wc, int fr, int fq) const {
        const int row0 = u.pm * BM + wr * 64 + fr; const int col0 = u.pn * HALF + wc * 32 + 8 * fq;
        float rs8[8]; rows_rstd(part, M, row0, fr, fq, rs8);
#pragma unroll
        for (int ai = 0; ai < 2; ++ai)
#pragma unroll
            for (int m = 0; m < 4; ++m) { const int row = row0 + ai * HALF + m * 16; const float rs = rs8[ai * 4 + m];
                const f32x4 g0 = acc[ai][0][m][0] * rs, g1 = acc[ai][0][m][1] * rs, u0 = acc[ai][1][m][0] * rs, u1 = acc[ai][1][m][1] * rs;
                u32x4 w; w.x = cvt_pk_bf16(silu_mul(g0[0], u0[0]), silu_mul(g0[1], u0[1])); w.y = cvt_pk_bf16(silu_mul(g0[2], u0[2]), silu_mul(g0[3], u0[3]));
                w.z = cvt_pk_bf16(silu_mul(g1[0], u1[0]), silu_mul(g1[1], u1[1])); w.w = cvt_pk_bf16(silu_mul(g1[2], u1[2]), silu_mul(g1[3], u1[3]));
                *(u32x4*)(H + (size_t)row * ldh + col0) = w; }
    }
};
struct EpiResid {
    static constexpr bool PERM = false, AFTER_DRAIN = false;
    bf16_t* xb; float* part; int M;
    __device__ __forceinline__ void operator()(const f32x4 (&acc)[2][2][4][2], const Unit& u, int wr, int wc, int fr, int fq) const {
        const int row0 = u.pm * BM + wr * 64 + fr; const int col0 = u.pn * BM + wc * 32 + 4 * fq;
        u32x2 bw[2][4][2][2];
#pragma unroll
        for (int ai = 0; ai < 2; ++ai)
#pragma unroll
            for (int m = 0; m < 4; ++m)
#pragma unroll
                for (int bj = 0; bj < 2; ++bj)
#pragma unroll
                    for (int n = 0; n < 2; ++n) bw[ai][m][bj][n] = *(const u32x2*)(xb + (size_t)(row0 + ai * HALF + m * 16) * 2048 + col0 + bj * HALF + n * 16);
        asm volatile("" ::: "memory");
#pragma unroll
        for (int ai = 0; ai < 2; ++ai)
#pragma unroll
            for (int m = 0; m < 4; ++m) { const int row = row0 + ai * HALF + m * 16; const size_t off = (size_t)row * 2048 + col0; float ss = 0.f;
#pragma unroll
                for (int bj = 0; bj < 2; ++bj)
#pragma unroll
                    for (int n = 0; n < 2; ++n) { const u32x2 b = bw[ai][m][bj][n]; f32x4 v = acc[ai][bj][m][n];
                        v[0] += __uint_as_float(b.x << 16); v[1] += __uint_as_float(b.x & 0xffff0000u); v[2] += __uint_as_float(b.y << 16); v[3] += __uint_as_float(b.y & 0xffff0000u);
                        ss += (v[0] * v[0] + v[1] * v[1]) + (v[2] * v[2] + v[3] * v[3]);
                        u32x2 w; w.x = cvt_pk_bf16(v[0], v[1]); w.y = cvt_pk_bf16(v[2], v[3]); *(u32x2*)(xb + off + bj * HALF + n * 16) = w; }
                ss += shx(ss, 16, (fr | (fq << 4))); ss += shx(ss, 32, (fr | (fq << 4)));
                if (fq == 0) part[(size_t)(u.pn * 4 + wc) * M + row] = ss; }
    }
};
template <class Epi, class Sched, bool ALIGN_EPI = false, bool SP2 = false>
__device__ __forceinline__ void gemm_phase(PG8_LAS unsigned char* lds, const Gemm g, const Sched& S, const Epi& E, int tid_in) {
    int tid_ = tid_in; asm volatile("" : "+v"(tid_));
    const int tid = tid_, wid = __builtin_amdgcn_readfirstlane(tid >> 6), lane = tid & 63, wr = wid >> 2, wc = wid & 3, fr = lane & 15, fq = lane >> 4;
    int K_ = g.K; asm volatile("" : "+s"(K_));
    const int K = K_, nt = K / BK;
    unsigned voffA[2], voffB[2];
#pragma unroll
    for (int i = 0; i < 2; ++i) { int R, C; stage_rc(tid * 16 + i * 8192, R, C); const int Rb = Epi::PERM ? ((R & ~31) + perm32(R & 31)) : R;
        voffA[i] = (unsigned)(R * K + C) * 2u; voffB[i] = (unsigned)(Rb * K + C) * 2u; }
    const size_t kstep = (size_t)(BK * 2);
    const size_t hstep = (size_t)HALF * K * 2;
    const size_t tstep = 2 * hstep;
    const unsigned ldsw = (unsigned)wid * 1024u;
    const int aoff = lds_byte(wr * 64 + fr, fq * 8), boff = lds_byte(wc * 32 + fr, fq * 8);
#define PG8_SA(b, h) (((b) * 2 + (h)) * HTB)
#define PG8_SB(b, h) ((4 + (b) * 2 + (h)) * HTB)
#define PG8_STAGE(bufoff, gbase, voff) do { _Pragma("unroll") for (int _i = 0; _i < 2; ++_i) \
        __builtin_amdgcn_global_load_lds((const unsigned*)((const char*)(gbase) + (voff)[_i]), (PG8_LAS unsigned*)(lds + (bufoff) + ldsw + _i * 8192), 16, 0, 0); } while (0)
#define PG8_LDA(dst, b, h) do { _Pragma("unroll") for (int m = 0; m < 4; ++m) _Pragma("unroll") for (int k = 0; k < 2; ++k) dst[m][k] = *(const PG8_LAS bf16x8*)(lds + PG8_SA(b, h) + aoff + m * 2048 + k * 1024); } while (0)
#define PG8_LDB(dst, b, h) do { _Pragma("unroll") for (int n = 0; n < 2; ++n) _Pragma("unroll") for (int k = 0; k < 2; ++k) dst[n][k] = *(const PG8_LAS bf16x8*)(lds + PG8_SB(b, h) + boff + n * 2048 + k * 1024); } while (0)
#define PG8_MMA(ai, bj, At, Bt) do { __builtin_amdgcn_s_setprio(1); _Pragma("unroll") for (int m = 0; m < 4; ++m) _Pragma("unroll") for (int n = 0; n < 2; ++n) _Pragma("unroll") for (int k = 0; k < 2; ++k) \
        acc[ai][bj][m][n] = __builtin_amdgcn_mfma_f32_16x16x32_bf16(Bt[n][k], At[m][k], acc[ai][bj][m][n], 0, 0, 0); __builtin_amdgcn_s_setprio(0); } while (0)
#define PG8_WAIT_V(n) asm volatile("s_waitcnt vmcnt(" #n ")" ::: "memory")
#define PG8_WAIT_L(n) asm volatile("s_waitcnt lgkmcnt(" #n ")" ::: "memory")
#define PG8_BAR __builtin_amdgcn_s_barrier()
#define PG8_SCHED __builtin_amdgcn_sched_barrier(0)
    Unit cur, nxt; int ui = 0;
    if (!S.next(0, cur)) return;
    f32x4 acc[2][2][4][2];
#pragma unroll
    for (int a = 0; a < 2; ++a)
#pragma unroll
        for (int b = 0; b < 2; ++b)
#pragma unroll
            for (int m = 0; m < 4; ++m)
#pragma unroll
                for (int n = 0; n < 2; ++n) acc[a][b][m][n] = (f32x4){0.f, 0.f, 0.f, 0.f};
    bf16x8 At[4][2], B0[2][2], B1[2][2];
    const char* cA = (const char*)g.A + (size_t)cur.pm * tstep; const char* cB = (const char*)g.Bt + (size_t)cur.pn * tstep;
    S.a_ready(cur);
    if constexpr (SP2) {
        PG8_STAGE(PG8_SB(0, 0), cB, voffB); PG8_STAGE(PG8_SB(0, 1), cB + hstep, voffB); PG8_STAGE(PG8_SA(0, 0), cA, voffA); PG8_STAGE(PG8_SA(0, 1), cA + hstep, voffA);
        if (wr == 1) PG8_BAR;
        PG8_WAIT_V(2); PG8_BAR;
        PG8_STAGE(PG8_SB(1, 0), cB + kstep, voffB); PG8_STAGE(PG8_SA(1, 0), cA + kstep, voffA); PG8_STAGE(PG8_SB(1, 1), cB + hstep + kstep, voffB);
        PG8_WAIT_V(6); PG8_BAR;
    } else {
        PG8_STAGE(PG8_SB(0, 0), cB, voffB); PG8_STAGE(PG8_SA(0, 0), cA, voffA); PG8_STAGE(PG8_SB(0, 1), cB + hstep, voffB); PG8_STAGE(PG8_SA(0, 1), cA + hstep, voffA);
        if (wr == 1) PG8_BAR;
        PG8_WAIT_V(4); PG8_BAR;
        PG8_STAGE(PG8_SB(1, 0), cB + kstep, voffB); PG8_STAGE(PG8_SA(1, 0), cA + kstep, voffA); PG8_STAGE(PG8_SB(1, 1), cB + hstep + kstep, voffB);
        PG8_WAIT_V(6); PG8_BAR;
    }
    for (;;) {
        const bool has_next = S.next(ui + 1, nxt);
        const char* nA = has_next ? (const char*)g.A + (size_t)nxt.pm * tstep : cA; const char* nB = has_next ? (const char*)g.Bt + (size_t)nxt.pn * tstep : cB;
        for (int t = 0; t < nt; t += 2) {
            const bool last = (t == nt - 2);
            const char* a1 = cA + (size_t)(t + 1) * kstep;
            const char* a2 = last ? nA : cA + (size_t)(t + 2) * kstep; const char* b2 = last ? nB : cB + (size_t)(t + 2) * kstep;
            const char* a3 = a2 + kstep; const char* b3 = b2 + kstep;
            if (last && has_next) S.a_ready(nxt);
            if constexpr (SP2) {
            PG8_LDB(B0, 0, 0); PG8_LDB(B1, 0, 1); PG8_SCHED; PG8_LDA(At, 0, 0); PG8_STAGE(PG8_SA(1, 1), a1 + hstep, voffA);
            PG8_WAIT_V(8); PG8_WAIT_L(0); PG8_BAR; PG8_MMA(0, 0, At, B0); PG8_MMA(0, 1, At, B1); PG8_BAR; PG8_SCHED;
            PG8_LDA(At, 0, 1); PG8_STAGE(PG8_SB(0, 0), b2, voffB); PG8_STAGE(PG8_SB(0, 1), b2 + hstep, voffB); PG8_STAGE(PG8_SA(0, 0), a2, voffA);
            PG8_WAIT_V(8); PG8_WAIT_L(0); PG8_BAR; PG8_MMA(1, 0, At, B0); PG8_MMA(1, 1, At, B1); PG8_BAR; PG8_SCHED;
            PG8_LDB(B0, 1, 0); PG8_LDB(B1, 1, 1); PG8_SCHED; PG8_LDA(At, 1, 0); PG8_STAGE(PG8_SA(0, 1), a2 + hstep, voffA);
            PG8_WAIT_V(8); PG8_WAIT_L(0); PG8_BAR; PG8_MMA(0, 0, At, B0); PG8_MMA(0, 1, At, B1); PG8_BAR; PG8_SCHED;
            PG8_LDA(At, 1, 1); PG8_STAGE(PG8_SB(1, 0), b3, voffB); PG8_STAGE(PG8_SB(1, 1), b3 + hstep, voffB); PG8_STAGE(PG8_SA(1, 0), a3, voffA);
            PG8_WAIT_V(8); PG8_WAIT_L(0); PG8_BAR; PG8_MMA(1, 0, At, B0); PG8_MMA(1, 1, At, B1); PG8_BAR; PG8_SCHED;
            } else {
            PG8_LDB(B0, 0, 0); PG8_SCHED; PG8_LDA(At, 0, 0); PG8_STAGE(PG8_SA(1, 1), a1 + hstep, voffA);
            PG8_WAIT_L(8); PG8_BAR; PG8_WAIT_L(0); PG8_MMA(0, 0, At, B0); PG8_BAR; PG8_SCHED;
            PG8_LDB(B1, 0, 1); PG8_STAGE(PG8_SB(0, 0), b2, voffB);
            PG8_BAR; PG8_WAIT_L(0); PG8_MMA(0, 1, At, B1); PG8_BAR;
            PG8_LDA(At, 0, 1); PG8_STAGE(PG8_SA(0, 0), a2, voffA);
            PG8_BAR; PG8_WAIT_L(0); PG8_MMA(1, 0, At, B0); PG8_BAR; PG8_SCHED;
            PG8_STAGE(PG8_SB(0, 1), b2 + hstep, voffB);
            PG8_WAIT_V(6); PG8_BAR; PG8_MMA(1, 1, At, B1); PG8_BAR;
            PG8_LDB(B0, 1, 0); PG8_SCHED; PG8_LDA(At, 1, 0); PG8_STAGE(PG8_SA(0, 1), a2 + hstep, voffA);
            PG8_WAIT_L(8); PG8_BAR; PG8_WAIT_L(0); PG8_MMA(0, 0, At, B0); PG8_BAR; PG8_SCHED;
            PG8_LDB(B1, 1, 1); PG8_STAGE(PG8_SB(1, 0), b3, voffB);
            PG8_BAR; PG8_WAIT_L(0); PG8_MMA(0, 1, At, B1); PG8_BAR;
            PG8_LDA(At, 1, 1); PG8_STAGE(PG8_SA(1, 0), a3, voffA);
            PG8_BAR; PG8_WAIT_L(0); PG8_MMA(1, 0, At, B0); PG8_BAR; PG8_SCHED;
            PG8_STAGE(PG8_SB(1, 1), b3 + hstep, voffB);
            PG8_WAIT_V(6); PG8_BAR; PG8_MMA(1, 1, At, B1); PG8_BAR;
            }
        }
        if constexpr (ALIGN_EPI) { if (wr == 0) PG8_BAR; }
        if constexpr (!Epi::AFTER_DRAIN) { E(acc, cur, wr, wc, fr, fq); S.done(cur); }
        if (!has_next) break;
#pragma unroll
        for (int a = 0; a < 2; ++a)
#pragma unroll
            for (int b = 0; b < 2; ++b)
#pragma unroll
                for (int m = 0; m < 4; ++m)
#pragma unroll
                    for (int n = 0; n < 2; ++n) acc[a][b][m][n] = (f32x4){0.f, 0.f, 0.f, 0.f};
        cur = nxt; cA = nA; cB = nB; ++ui;
        if constexpr (ALIGN_EPI) { if (wr == 1) PG8_BAR; }
    }
    PG8_WAIT_V(0);
    if constexpr (!ALIGN_EPI) { if (wr == 0) PG8_BAR; }
    PG8_BAR;
    if constexpr (Epi::AFTER_DRAIN) { E.fused(acc, cur, wr, wc, fr, fq, lds, wid, lane); S.done(cur); }
#undef PG8_SA
#undef PG8_SB
#undef PG8_STAGE
#undef PG8_LDA
#undef PG8_LDB
#undef PG8_MMA
#undef PG8_WAIT_V
#undef PG8_WAIT_L
#undef PG8_BAR
#undef PG8_SCHED
}
}
#ifndef PG8_SP2
#define PG8_SP2 true
#endif
#ifndef PG8_ALIGN
#define PG8_ALIGN true
#endif
#ifndef RPT_AC
#define RPT_AC 1
#endif
#ifndef RPT_GEMM
#define RPT_GEMM 1
#endif
#ifndef RPT_B3
#define RPT_B3 1
#endif
#ifndef MK_PER_PHASE
#define MK_PER_PHASE 0
#endif

constexpr int DM = 2048, MT = 32768, NIN = 5120, DFF = 5632, NGU = 2 * DFF, NL = 2;
constexpr int C_QA = 0, C_KA = 768, C_VA = 1536, C_QR = 2304, C_KR = 2560, C_VR = 2816, C_GR = 3328, C_QC = 3840, C_KC = 4608, C_VC = 4864;
constexpr int MX_A = 0, MX_R = 768, MX_C = 1280;
constexpr int NWAVES = 8, NTHR = 512;
constexpr float LOG2E = 1.4426950408889634f;
constexpr size_t MiB = 1u << 20;
constexpr size_t WS_LUTA = 1 * MiB, WS_LUTC = 1 * MiB + 32768, WS_PAR = 1 * MiB + 65536, WS_CS = 2 * MiB;
constexpr size_t WS_W = 4 * MiB, W_IN = 0, W_OUT = 20 * MiB, W_GU = 28 * MiB, W_DN = 72 * MiB, W_LAYER = 94 * MiB;
constexpr size_t WS_XB = 192 * MiB, WS_PROJ = 320 * MiB, WS_MIX = 640 * MiB, WS_H = WS_PROJ, WS_PART = 768 * MiB, WS_KVF = 772 * MiB, WS_KVB = 788 * MiB, WS_END = 804 * MiB;
static_assert(WS_W + NL * W_LAYER <= WS_XB && (size_t)MT * DFF * 2 <= WS_PART - WS_H, "ws map");
constexpr int RING_BYTES = 131072, LDS_BYTES = 147456;
constexpr int WLDS = 16384;

#define LAS __attribute__((address_space(3)))
typedef unsigned short bf16_t;
typedef unsigned u32x4 __attribute__((ext_vector_type(4)));
typedef unsigned u32x2 __attribute__((ext_vector_type(2)));
typedef float f32x4 __attribute__((ext_vector_type(4)));
typedef float f32x2 __attribute__((ext_vector_type(2)));
typedef short bf16x8 __attribute__((ext_vector_type(8)));
typedef short s16x4 __attribute__((ext_vector_type(4)));
__device__ __forceinline__ float bf2f(unsigned short v) { return __uint_as_float((unsigned)v << 16); }
__device__ __forceinline__ unsigned pk2(float lo, float hi) { return pg8::cvt_pk_bf16(lo, hi); }
__device__ __forceinline__ float ex2(float x) { return __builtin_amdgcn_exp2f(x); }
__device__ __forceinline__ float wave_sum(float v, int lane) {
#pragma unroll
    for (int o = 1; o < 64; o <<= 1) v += shx(v, o, lane);
    return v;
}
__device__ __forceinline__ s16x4 tr16(const LAS unsigned char* p) { return __builtin_bit_cast(s16x4, __builtin_amdgcn_ds_read_tr16_b64_v4i16((LAS s16x4*)p)); }
#define MFMA16(a, b, c) __builtin_amdgcn_mfma_f32_16x16x32_bf16(a, b, c, 0, 0, 0)

__constant__ double ROPE_FR[16] = {0.15915494309189535, 0.08949940160889101, 0.050329212104487035, 0.0283021958306234, 0.015915494309189534, 0.008949940160889102, 0.005032921210448704, 0.00283021958306234,
    0.0015915494309189536, 0.0008949940160889102, 0.0005032921210448703, 0.00028302195830623395, 0.00015915494309189535, 8.949940160889102e-05, 5.0329212104487035e-05, 2.8302195830623396e-05};

#define RLX_AGENT __ATOMIC_RELAXED, __HIP_MEMORY_SCOPE_AGENT
#define XB_TMO      128
#define XB_XCNT(j)  (256  + 64 * (j))
#define XB_XSUB(j)  (1280 + 64 * (j))
#define XB_XGEN(j)  (2304 + 64 * (j))
#define XB_TOP      3328
#define XB_TOPGEN   3392
#define XCD_BAR_WORDS 3456
#define XB_SPIN_CAP (1u << 18)

__device__ __forceinline__ unsigned xb_ld(unsigned* p)              { return __hip_atomic_load(p, __ATOMIC_RELAXED, __HIP_MEMORY_SCOPE_AGENT); }
__device__ __forceinline__ unsigned xb_add(unsigned* p, unsigned v) { return __hip_atomic_fetch_add(p, v, __ATOMIC_RELAXED, __HIP_MEMORY_SCOPE_AGENT); }
__device__ __forceinline__ unsigned xb_xcc_id() { return (unsigned)__builtin_amdgcn_s_getreg((3 << 11) | 20) & 0xFu; }
#define XB_SPIN(cond, bar) do { unsigned _sp = 0; while (cond) { __builtin_amdgcn_s_sleep(1); \
    if ((++_sp & 255u) == 0u) { if (xb_ld(&(bar)[XB_TMO])) break; if (_sp > XB_SPIN_CAP) { atomicAdd(&(bar)[XB_TMO], 1u); break; } } } } while (0)

struct XcdBarrier {
    unsigned* bar; unsigned x;
    volatile LAS unsigned* st;
};

__device__ __forceinline__ XcdBarrier xcd_barrier_post(unsigned* bar, volatile LAS unsigned* st, bool is_t0) {
    XcdBarrier b; b.bar = bar; b.x = xb_xcc_id(); b.st = st;
    if (is_t0) (void)xb_add(&bar[XB_XCNT(b.x)], 1u);
    return b;
}
__device__ __forceinline__ void xcd_barrier_complete(unsigned* bar, unsigned x, unsigned& nloc, unsigned& nx) {
    const unsigned G = gridDim.x * gridDim.y * gridDim.z;
    unsigned sum, cnt, mine, sp = 0u;
    for (;;) {
        sum = 0u; cnt = 0u; mine = 0u;
#pragma unroll
        for (unsigned j = 0; j < 16; ++j) { const unsigned c = xb_ld(&bar[XB_XCNT(j)]); sum += c; cnt += (c > 0u) ? 1u : 0u; mine = (j == x) ? c : mine; }
        if (sum == G) break;
        __builtin_amdgcn_s_sleep(1);
        if ((++sp & 255u) == 0u) { if (xb_ld(&bar[XB_TMO])) break; if (sp > XB_SPIN_CAP) { atomicAdd(&bar[XB_TMO], 1u); break; } }
    }
    nloc = mine > 0u ? mine : 1u; nx = cnt > 0u ? cnt : 1u;
}

__device__ __forceinline__ void xcd_barrier(const XcdBarrier& b, bool is_t0) {
    asm volatile("s_waitcnt vmcnt(0)" ::: "memory");
    __syncthreads();
    if (is_t0) {
        unsigned* bar = b.bar;
        __builtin_amdgcn_s_waitcnt(0);
        unsigned nloc = b.st[0], nx = b.st[1];
        if (nloc == 0u) { xcd_barrier_complete(bar, b.x, nloc, nx); b.st[0] = nloc; b.st[1] = nx; }
        const unsigned old = xb_add(&bar[XB_XSUB(b.x)], 1u);
        const unsigned gen = old / nloc;
        if (old + 1u == (gen + 1u) * nloc) {
            __builtin_amdgcn_fence(__ATOMIC_RELEASE, "agent");
            asm volatile("s_waitcnt vmcnt(0)" ::: "memory");
            const unsigned og = xb_add(&bar[XB_TOP], 1u);
            const unsigned tg = og / nx;
            if (og + 1u == (tg + 1u) * nx) xb_add(&bar[XB_TOPGEN], 1u);
            else XB_SPIN(xb_ld(&bar[XB_TOPGEN]) == tg, bar);
            __builtin_amdgcn_fence(__ATOMIC_ACQUIRE, "agent");
            xb_add(&bar[XB_XGEN(b.x)], 1u);
            asm volatile("s_waitcnt vmcnt(0)" ::: "memory");
        } else {
            XB_SPIN(xb_ld(&bar[XB_XGEN(b.x)]) == gen, bar);
            __builtin_amdgcn_fence(__ATOMIC_ACQUIRE, "agent");
            asm volatile("s_waitcnt vmcnt(0)" ::: "memory");
        }
    }
    __syncthreads();
}

struct Trunk { const float* x; float* out; int nseq, S; };
struct Frame {
    LAS unsigned char* lds; int tid, lane, wave, G, bx, gw, NGW;
    unsigned char* ws;
};

struct TrItem { const float* W; const float* gain; bf16_t* WT; int K, N, k0, n0, drow0; };
__device__ __forceinline__ void tr_load(const TrItem& t, int lane, float (&wv)[32]) {
#pragma unroll
    for (int i = 0; i < 32; ++i) wv[i] = t.W[(size_t)(t.k0 + 2 * i + (lane >> 5)) * t.N + t.n0 + (lane & 31)];
}
__device__ __forceinline__ void tr_store(const TrItem& t, LAS float* scr, int lane, float (&wv)[32]) {
    if (t.gain) {
#pragma unroll
        for (int i = 0; i < 32; ++i) wv[i] *= t.gain[t.k0 + 2 * i + (lane >> 5)]; }
#pragma unroll
    for (int i = 0; i < 32; ++i) scr[(2 * i + (lane >> 5)) * 33 + (lane & 31)] = wv[i];
    asm volatile("s_waitcnt lgkmcnt(0)" ::: "memory");
    const int c = lane & 7;
#pragma unroll
    for (int j = 0; j < 4; ++j) { const int n = (lane >> 3) + 8 * j; const LAS float* s = scr + (8 * c) * 33 + n;
        u32x4 o; o.x = pk2(s[0 * 33], s[1 * 33]); o.y = pk2(s[2 * 33], s[3 * 33]); o.z = pk2(s[4 * 33], s[5 * 33]); o.w = pk2(s[6 * 33], s[7 * 33]);
        *(u32x4*)(t.WT + (size_t)(t.drow0 + n) * t.K + t.k0 + 8 * c) = o; }
    asm volatile("s_waitcnt lgkmcnt(0)" ::: "memory");
}
__device__ __forceinline__ int t5_bucket(int rel) {
    const int n = rel < 0 ? -rel : rel;
    const int b = n < 8 ? n : 8 + (n >= 15) + (n >= 27) + (n >= 50) + (n >= 91) + (n >= 166) + (n >= 305) + (n >= 559);
    return (rel > 0 ? 16 : 0) + b;
}
__device__ __forceinline__ float decay_lg2(float a) {
    const float x = ex2(-a);
    if (x > 0.1f) return __log2f(1.0f - x);
    const float s = x * (1.f + x * (0.5f + x * (1.f / 3 + x * (0.25f + x * (0.2f + x * (1.f / 6 + x * (1.f / 7)))))));
    return -s * LOG2E;
}
__device__ __forceinline__ void weights_prologue(Frame& F, const float* const (&in)[14]) {
    LAS float* scr = (LAS float*)(F.lds + F.wave * WLDS);
    constexpr int I_IN = 32 * 160, I_OUT = 32 * 64, I_G = 32 * 176, I_D = 88 * 64, I_LAYER = I_IN + I_OUT + 2 * I_G + I_D;
    auto decode = [&](int it, TrItem& t) {
        const int l = it / I_LAYER; int r = it % I_LAYER; unsigned char* wl = F.ws + WS_W + (size_t)l * W_LAYER;
        if (r < I_IN) { const int kb = r / 160, nb = r % 160; t = TrItem{in[4] + (size_t)l * DM * NIN, in[3] + l * DM, (bf16_t*)(wl + W_IN), DM, NIN, 64 * kb, 32 * nb, 32 * nb}; return; } r -= I_IN;
        if (r < I_OUT) { const int kb = r / 64, nb = r % 64; t = TrItem{in[8] + (size_t)l * DM * DM, nullptr, (bf16_t*)(wl + W_OUT), DM, DM, 64 * kb, 32 * nb, 32 * nb}; return; } r -= I_OUT;
        if (r < 2 * I_G) { const int up = r >= I_G; if (up) r -= I_G; const int kb = r / 176, nb = r % 176; const int n0 = 32 * nb;
            t = TrItem{in[up ? 11 : 10] + (size_t)l * DM * DFF, in[9] + l * DM, (bf16_t*)(wl + W_GU), DM, DFF, 64 * kb, n0, (n0 >> 7) * 256 + (n0 & 127) + (up ? 128 : 0)}; return; } r -= 2 * I_G;
        { const int kb = r / 64, nb = r % 64; t = TrItem{in[12] + (size_t)l * DFF * DM, nullptr, (bf16_t*)(wl + W_DN), DFF, DM, 64 * kb, 32 * nb, 32 * nb}; }
    };
    {
        TrItem tc, tn; float wa[32], wb[32]; int it = F.gw;
        if (it < NL * I_LAYER) { decode(it, tc); tr_load(tc, F.lane, wa); }
        while (it < NL * I_LAYER) {
            const int itn = it + F.NGW; const bool more = itn < NL * I_LAYER;
            if (more) { decode(itn, tn); tr_load(tn, F.lane, wb); }
            tr_store(tc, scr, F.lane, wa);
            if (!more) break;
            const int itn2 = itn + F.NGW; const bool more2 = itn2 < NL * I_LAYER;
            if (more2) { decode(itn2, tc); tr_load(tc, F.lane, wa); }
            tr_store(tn, scr, F.lane, wb);
            if (!more2) break;
            it = itn2;
        }
    }
    const int gt = F.bx * NTHR + F.tid, NGT = F.G * NTHR;
    const float* rb = in[2];
    float* lutA = (float*)(F.ws + WS_LUTA); float* lutC = (float*)(F.ws + WS_LUTC);
    for (int i = gt; i < 12 * 387 + 12 * 257; i += NGT) {
        if (i < 12 * 387) { const int h = i / 387, r = i % 387, br = r / 129, mm = r % 129 - 64; const int dil = br == 0 ? 1 : (br == 1 ? 4 : 16);
            lutA[i] = rb[t5_bucket(mm * dil) * 24 + h] * LOG2E; }
        else { const int j = i - 12 * 387, h = j / 257, off = j % 257 - 128; lutC[j] = rb[t5_bucket(off) * 24 + 12 + h] * LOG2E; }
    }
    float* par = (float*)(F.ws + WS_PAR);
    for (int i = gt; i < 64 + 2048; i += NGT) {
        if (i < 16) par[i] = decay_lg2(in[5][i]);
        else if (i < 32) par[i] = decay_lg2(in[6][i - 16]);
        else if (i < 56) par[i] = in[7][i - 32] * LOG2E;
        else if (i >= 64) par[i] = in[13][i - 64];
    }
    f32x2* cs = (f32x2*)(F.ws + WS_CS);
    for (int i = gt; i < 16384 * 16; i += NGT) { const int pos = i >> 4, j = i & 15; double rev = (double)pos * ROPE_FR[j]; rev -= __builtin_rint(rev); const float r = (float)rev;
        cs[i] = (f32x2){__builtin_amdgcn_cosf(r), __builtin_amdgcn_sinf(r)}; }
}
__device__ __forceinline__ void trunk_prologue(Frame& F, const Trunk& T) {
    bf16_t* xb = (bf16_t*)(F.ws + WS_XB); float* part = (float*)(F.ws + WS_PART);
    for (int row = F.gw; row < MT; row += 2 * F.NGW) {
        const int row2 = row + F.NGW;
        const f32x4* xr = (const f32x4*)(T.x + (size_t)row * DM) + F.lane; const f32x4* xr2 = (const f32x4*)(T.x + (size_t)row2 * DM) + F.lane; f32x4 v1[8], v2[8];
#pragma unroll
        for (int j = 0; j < 8; ++j) { v1[j] = xr[64 * j]; v2[j] = xr2[64 * j]; }
#pragma unroll
        for (int rr = 0; rr < 2; ++rr) { float s = 0.f; const int r = rr ? row2 : row;
            u32x2* o = (u32x2*)(xb + (size_t)r * DM) + F.lane;
#pragma unroll
            for (int j = 0; j < 8; ++j) { const f32x4 v = rr ? v2[j] : v1[j]; s += (v[0] * v[0] + v[1] * v[1]) + (v[2] * v[2] + v[3] * v[3]);
                u32x2 w; w.x = pk2(v[0], v[1]); w.y = pk2(v[2], v[3]); o[64 * j] = w; }
            s = wave_sum(s, F.lane);
            if (F.lane < 32) part[(size_t)F.lane * MT + r] = F.lane == 0 ? s : 0.f; }
    }
}
__device__ __forceinline__ void final_norm(Frame& F, const Trunk& T) {
    const f32x4* g4 = (const f32x4*)((const float*)(F.ws + WS_PAR) + 64) + F.lane; const bf16_t* xb = (const bf16_t*)(F.ws + WS_XB);
    for (int row = F.gw; row < MT; row += 2 * F.NGW) {
        const int row2 = row + F.NGW;
        const u32x2* xr = (const u32x2*)(xb + (size_t)row * DM) + F.lane; const u32x2* xr2 = (const u32x2*)(xb + (size_t)row2 * DM) + F.lane; u32x2 b1[8], b2[8];
#pragma unroll
        for (int j = 0; j < 8; ++j) { b1[j] = xr[64 * j]; b2[j] = xr2[64 * j]; }
#pragma unroll
        for (int rr = 0; rr < 2; ++rr) { f32x4 v[8]; float s = 0.f;
#pragma unroll
            for (int j = 0; j < 8; ++j) { const u32x2 b = rr ? b2[j] : b1[j]; v[j] = (f32x4){__uint_as_float(b.x << 16), __uint_as_float(b.x & 0xffff0000u), __uint_as_float(b.y << 16), __uint_as_float(b.y & 0xffff0000u)};
                s += (v[j][0] * v[j][0] + v[j][1] * v[j][1]) + (v[j][2] * v[j][2] + v[j][3] * v[j][3]); }
            const float rs = rsqrtf(wave_sum(s, F.lane) * (1.0f / DM) + 1e-6f);
            f32x4* yr = (f32x4*)(T.out + (size_t)(rr ? row2 : row) * DM) + F.lane;
#pragma unroll
            for (int j = 0; j < 8; ++j) yr[64 * j] = v[j] * rs * g4[64 * j]; }
    }
}
constexpr int VPITCH = 144;
__device__ __forceinline__ void stage_v_regs(const u32x4 (&v)[4], LAS unsigned char* vimg, int lane, bf16x8 (&vf)[4]) {
    LAS unsigned char* d = vimg + (lane >> 3) * VPITCH + (lane & 7) * 16;
#pragma unroll
    for (int i = 0; i < 4; ++i) *(LAS u32x4*)(d + 8 * i * VPITCH) = v[i];
    asm volatile("" ::: "memory");
    const int i16 = lane & 15, quad = lane >> 4;
    const LAS unsigned char* b = vimg + (4 * quad + (i16 >> 2)) * VPITCH + (i16 & 3) * 8;
#pragma unroll
    for (int nn = 0; nn < 4; ++nn) { const s16x4 lo = tr16(b + nn * 32), hi = tr16(b + 16 * VPITCH + nn * 32); vf[nn] = (bf16x8){lo[0], lo[1], lo[2], lo[3], hi[0], hi[1], hi[2], hi[3]}; }
    asm volatile("" ::: "memory");
}
__device__ __forceinline__ void rope8(const bf16x8 x1, const bf16x8 x2, const f32x2* cs8, float sc, float (&y1)[8], float (&y2)[8]) {
    const f32x4* c4 = (const f32x4*)cs8; const f32x4 t0 = c4[0], t1 = c4[1], t2 = c4[2], t3 = c4[3];
    const float co[8] = {t0[0], t0[2], t1[0], t1[2], t2[0], t2[2], t3[0], t3[2]}, si[8] = {t0[1], t0[3], t1[1], t1[3], t2[1], t2[3], t3[1], t3[3]};
#pragma unroll
    for (int j = 0; j < 8; ++j) { const float a = bf2f((unsigned short)x1[j]), bb = bf2f((unsigned short)x2[j]); y1[j] = (a * co[j] - bb * si[j]) * sc; y2[j] = (a * si[j] + bb * co[j]) * sc; }
}
__device__ __forceinline__ u32x4 pack8(const float (&y)[8], float w) { u32x4 r; r.x = pk2(y[0] * w, y[1] * w); r.y = pk2(y[2] * w, y[3] * w); r.z = pk2(y[4] * w, y[5] * w); r.w = pk2(y[6] * w, y[7] * w); return r; }
constexpr int KPITCH = 80;
__device__ __forceinline__ void ret_chunk_states(Frame& F, const Trunk& T, int layer) {
    bf16_t* proj = (bf16_t*)(F.ws + WS_PROJ); const f32x2* cs = (const f32x2*)(F.ws + WS_CS);
    float* kvf = (float*)(F.ws + WS_KVF); float* kvb = (float*)(F.ws + WS_KVB);
    LAS unsigned char* vimg = F.lds + F.wave * WLDS; LAS unsigned char* kfimg = vimg + 32 * VPITCH; LAS unsigned char* kbimg = kfimg + 32 * KPITCH;
    const int cps = T.S / 128, lane = F.lane, i16 = lane & 15, quad = lane >> 4; const f32x4 z4 = {0.f, 0.f, 0.f, 0.f};
    for (int it = F.gw; it < 256 * 8; it += F.NGW) {
        const int gch = it >> 3, h = it & 7, b = gch / cps, c = gch % cps, pos0 = c * 128; const size_t row0 = (size_t)b * T.S + pos0;
        const float* par = (const float*)(F.ws + WS_PAR); const float lgf = par[layer * 8 + h], lgb = par[16 + layer * 8 + h];
        { bf16x8 xa[4], xc[4]; f32x4 cq[4][4];
#pragma unroll
          for (int q4 = 0; q4 < 4; ++q4) { const int idx = q4 * 64 + lane, row = idx >> 1, cc = idx & 1;
              const bf16_t* p = proj + (row0 + row) * NIN + C_QR + h * 32 + 8 * cc; xa[q4] = *(const bf16x8*)p; xc[q4] = *(const bf16x8*)(p + 16);
              const f32x4* c4 = (const f32x4*)(cs + (size_t)(pos0 + row) * 16 + 8 * cc); cq[q4][0] = c4[0]; cq[q4][1] = c4[1]; cq[q4][2] = c4[2]; cq[q4][3] = c4[3]; }
          asm volatile("" ::: "memory");
#pragma unroll
          for (int q4 = 0; q4 < 4; ++q4) { const int idx = q4 * 64 + lane, row = idx >> 1, cc = idx & 1;
              bf16_t* p = proj + (row0 + row) * NIN + C_QR + h * 32 + 8 * cc;
              const f32x4 t0 = cq[q4][0], t1 = cq[q4][1], t2 = cq[q4][2], t3 = cq[q4][3];
              const float co[8] = {t0[0], t0[2], t1[0], t1[2], t2[0], t2[2], t3[0], t3[2]}, si[8] = {t0[1], t0[3], t1[1], t1[3], t2[1], t2[3], t3[1], t3[3]};
              float y1[8], y2[8];
#pragma unroll
              for (int j = 0; j < 8; ++j) { const float a = bf2f((unsigned short)xa[q4][j]), bb = bf2f((unsigned short)xc[q4][j]); y1[j] = a * co[j] - bb * si[j]; y2[j] = a * si[j] + bb * co[j]; }
              *(u32x4*)p = pack8(y1, 1.0f); *(u32x4*)(p + 16) = pack8(y2, 1.0f); } }
        f32x4 af[4][2], ab[4][2];
#pragma unroll
        for (int nn = 0; nn < 4; ++nn) { af[nn][0] = z4; af[nn][1] = z4; ab[nn][0] = z4; ab[nn][1] = z4; }
        const bf16_t* vp = proj + row0 * NIN + C_VR + h * 64;
#pragma unroll 1
        for (int t = 0; t < 4; ++t) {
            u32x4 vraw[4];
#pragma unroll
            for (int i = 0; i < 4; ++i) vraw[i] = *(const u32x4*)(vp + (size_t)(32 * t + 8 * i + (lane >> 3)) * NIN + (lane & 7) * 8);
            { const int row = lane >> 1, cc = lane & 1, sg = 32 * t + row;
                bf16_t* p = proj + (row0 + sg) * NIN + C_KR + h * 32 + 8 * cc;
                float y1[8], y2[8]; rope8(*(const bf16x8*)p, *(const bf16x8*)(p + 16), cs + (size_t)(pos0 + sg) * 16 + 8 * cc, 0.17677669529663687f, y1, y2);
                *(u32x4*)p = pack8(y1, 1.0f); *(u32x4*)(p + 16) = pack8(y2, 1.0f);
                const float wf = ex2(lgf * (float)(127 - sg)), wb = ex2(lgb * (float)sg);
                *(LAS u32x4*)(kfimg + row * KPITCH + 16 * cc) = pack8(y1, wf); *(LAS u32x4*)(kfimg + row * KPITCH + 32 + 16 * cc) = pack8(y2, wf);
                *(LAS u32x4*)(kbimg + row * KPITCH + 16 * cc) = pack8(y1, wb); *(LAS u32x4*)(kbimg + row * KPITCH + 32 + 16 * cc) = pack8(y2, wb); }
            bf16x8 vf[4]; stage_v_regs(vraw, vimg, lane, vf);
            bf16x8 kff[2], kbf[2];
            { const int ro = (4 * quad + (i16 >> 2)) * KPITCH + (i16 & 3) * 8;
#pragma unroll
                for (int nt = 0; nt < 2; ++nt) { const s16x4 l0 = tr16(kfimg + ro + nt * 32), h0 = tr16(kfimg + ro + 16 * KPITCH + nt * 32), l1 = tr16(kbimg + ro + nt * 32), h1 = tr16(kbimg + ro + 16 * KPITCH + nt * 32);
                    kff[nt] = (bf16x8){l0[0], l0[1], l0[2], l0[3], h0[0], h0[1], h0[2], h0[3]}; kbf[nt] = (bf16x8){l1[0], l1[1], l1[2], l1[3], h1[0], h1[1], h1[2], h1[3]}; } }
            asm volatile("" ::: "memory");
#pragma unroll
            for (int nn = 0; nn < 4; ++nn)
#pragma unroll
                for (int nt = 0; nt < 2; ++nt) { af[nn][nt] = MFMA16(vf[nn], kff[nt], af[nn][nt]); ab[nn][nt] = MFMA16(vf[nn], kbf[nt], ab[nn][nt]); }
        }
        float* of = kvf + (size_t)(gch * 8 + h) * 2048; float* ob = kvb + (size_t)(gch * 8 + h) * 2048;
#pragma unroll
        for (int nn = 0; nn < 4; ++nn)
#pragma unroll
            for (int nt = 0; nt < 2; ++nt)
#pragma unroll
                for (int j = 0; j < 4; ++j) { const int o = (16 * nn + 4 * quad + j) * 32 + 16 * nt + i16; of[o] = af[nn][nt][j]; ob[o] = ab[nn][nt][j]; }
    }
}
__device__ __forceinline__ void ret_scan(Frame& F, const Trunk& T, int layer) {
    const int n = T.S / 128, per_dir = T.nseq * 8 * 2048, gt = F.bx * NTHR + F.tid, NGT = F.G * NTHR;
    for (int idx = gt; idx < 2 * per_dir; idx += NGT) {
        const int dir = idx / per_dir, rem = idx % per_dir, b = rem / (8 * 2048), h = (rem >> 11) & 7, e = rem & 2047;
        const float g = ex2(128.f * ((const float*)(F.ws + WS_PAR))[dir * 16 + layer * 8 + h]);
        float* p = (float*)(F.ws + (dir ? WS_KVB : WS_KVF)) + ((size_t)(b * n) * 8 + h) * 2048 + e; const size_t cst = 8 * 2048;
        float R = 0.f;
        if (dir == 0) { for (int c0 = 0; c0 < n; c0 += 16) { float t[16];
#pragma unroll
                for (int u = 0; u < 16; ++u) t[u] = p[(size_t)(c0 + u) * cst];
#pragma unroll
                for (int u = 0; u < 16; ++u) { p[(size_t)(c0 + u) * cst] = R; R = R * g + t[u]; } } }
        else { for (int c0 = n - 16; c0 >= 0; c0 -= 16) { float t[16];
#pragma unroll
                for (int u = 0; u < 16; ++u) t[u] = p[(size_t)(c0 + u) * cst];
#pragma unroll
                for (int u = 15; u >= 0; --u) { p[(size_t)(c0 + u) * cst] = R; R = t[u] + g * R; } } }
    }
}
__device__ __forceinline__ void stage_v(const bf16_t* vrow  , LAS unsigned char* vimg, int lane, bf16x8 (&vf)[4]) {
    const u32x4* p = (const u32x4*)vrow; const u32x4 v0 = p[0], v1 = p[1], v2 = p[2], v3 = p[3];
    LAS u32x4* d = (LAS u32x4*)(vimg + (lane >> 1) * VPITCH + (lane & 1) * 64);
    d[0] = v0; d[1] = v1; d[2] = v2; d[3] = v3;
    asm volatile("" ::: "memory");
    const int i16 = lane & 15, quad = lane >> 4;
    const LAS unsigned char* b = vimg + (4 * quad + (i16 >> 2)) * VPITCH + (i16 & 3) * 8;
#pragma unroll
    for (int nn = 0; nn < 4; ++nn) { const s16x4 lo = tr16(b + nn * 32), hi = tr16(b + 16 * VPITCH + nn * 32); vf[nn] = (bf16x8){lo[0], lo[1], lo[2], lo[3], hi[0], hi[1], hi[2], hi[3]}; }
    asm volatile("" ::: "memory");
}
struct TileLdR { bf16x8 k[2]; u32x4 v[4]; };
__device__ __forceinline__ void tile_load_r(TileLdR& L, const bf16_t* kp  , const bf16_t* vp, int t, int lane) {
    const int i16 = lane & 15, quad = lane >> 4;
#pragma unroll
    for (int st = 0; st < 2; ++st) L.k[st] = *(const bf16x8*)(kp + (size_t)(32 * t + 16 * st + i16) * NIN + quad * 8);
#pragma unroll
    for (int i = 0; i < 4; ++i) L.v[i] = *(const u32x4*)(vp + (size_t)(32 * t + 8 * i + (lane >> 3)) * NIN + (lane & 7) * 8);
}
__device__ __forceinline__ void ret_output(Frame& F, const Trunk& T, int layer) {
    const bf16_t* proj = (const bf16_t*)(F.ws + WS_PROJ); bf16_t* mix = (bf16_t*)(F.ws + WS_MIX);
    const float* kvf = (const float*)(F.ws + WS_KVF); const float* kvb = (const float*)(F.ws + WS_KVB);
    LAS unsigned char* vimg = F.lds + F.wave * WLDS;
    const int cps = T.S / 128, lane = F.lane, i16 = lane & 15, quad = lane >> 4;
    const f32x4 z4 = {0.f, 0.f, 0.f, 0.f};
    for (int it = F.gw; it < 256 * 8; it += F.NGW) {
        const int gch = it >> 3, h = it & 7, b = gch / cps, c = gch % cps; const size_t row0 = (size_t)b * T.S + c * 128;
        const float* par = (const float*)(F.ws + WS_PAR); const float lgf = par[layer * 8 + h], lgb = par[16 + layer * 8 + h];
        const bf16_t* kp = proj + row0 * NIN + C_KR + h * 32; const bf16_t* vp = proj + row0 * NIN + C_VR + h * 64;
#pragma unroll 1
        for (int half = 0; half < 2; ++half) {
        TileLdR cur, nxt; tile_load_r(cur, kp, vp, 0, lane);
        bf16x8 qf[4];
#pragma unroll
        for (int qt = 0; qt < 4; ++qt) qf[qt] = *(const bf16x8*)(proj + (row0 + 64 * half + 16 * qt + i16) * NIN + C_QR + h * 32 + quad * 8);
        f32x4 o[4][4];
#pragma unroll
        for (int qt = 0; qt < 4; ++qt) { o[qt][0] = z4; o[qt][1] = z4; o[qt][2] = z4; o[qt][3] = z4; }
#pragma unroll 1
        for (int t = 0; t < 4; ++t) {
            if (t + 1 < 4) tile_load_r(nxt, kp, vp, t + 1, lane);
            bf16x8 vf[4]; stage_v_regs(cur.v, vimg, lane, vf);
            const int sg0 = 32 * t + 4 * quad - i16 - 64 * half;
#pragma unroll
            for (int qt = 0; qt < 4; ++qt) { float p[8];
#pragma unroll
                for (int st = 0; st < 2; ++st) { const f32x4 s = MFMA16(cur.k[st], qf[qt], z4);
#pragma unroll
                    for (int jj = 0; jj < 4; ++jj) { const int nd = sg0 + 16 * st + jj - 16 * qt;
                        const float w = nd <= 0 ? ex2(lgf * (float)(-nd)) : ex2(lgb * (float)nd); p[4 * st + jj] = s[jj] * w; } }
                const u32x4 pw = {pk2(p[0], p[1]), pk2(p[2], p[3]), pk2(p[4], p[5]), pk2(p[6], p[7])}; const bf16x8 pf = __builtin_bit_cast(bf16x8, pw);
#pragma unroll
                for (int nn = 0; nn < 4; ++nn) o[qt][nn] = MFMA16(vf[nn], pf, o[qt][nn]); }
            cur = nxt;
        }
        bf16x8 rf[4], rb[4];
#pragma unroll
        for (int nn = 0; nn < 4; ++nn) { const size_t oo = ((size_t)(gch * 8 + h) * 64 + 16 * nn + i16) * 32 + quad * 8;
            const f32x4 a0 = *(const f32x4*)(kvf + oo), a1 = *(const f32x4*)(kvf + oo + 4), b0 = *(const f32x4*)(kvb + oo), b1 = *(const f32x4*)(kvb + oo + 4);
            const u32x4 wa = {pk2(a0[0], a0[1]), pk2(a0[2], a0[3]), pk2(a1[0], a1[1]), pk2(a1[2], a1[3])}, wb = {pk2(b0[0], b0[1]), pk2(b0[2], b0[3]), pk2(b1[0], b1[1]), pk2(b1[2], b1[3])};
            rf[nn] = __builtin_bit_cast(bf16x8, wa); rb[nn] = __builtin_bit_cast(bf16x8, wb); }
#pragma unroll
        for (int qt = 0; qt < 4; ++qt) {
            const int tau = 64 * half + 16 * qt + i16; const size_t qrow = row0 + tau;
            const float wqf = ex2(lgf * (float)(tau + 1)), wqb = ex2(lgb * (float)(128 - tau));
            float s1 = 0.f;
#pragma unroll
            for (int nn = 0; nn < 4; ++nn) { const f32x4 xf = MFMA16(rf[nn], qf[qt], z4), xb = MFMA16(rb[nn], qf[qt], z4); o[qt][nn] = o[qt][nn] + xf * wqf + xb * wqb; s1 += (o[qt][nn][0] + o[qt][nn][1]) + (o[qt][nn][2] + o[qt][nn][3]); }
            s1 += shx(s1, 16, lane); s1 += shx(s1, 32, lane); const float mu = s1 * (1.f / 64.f); float s2 = 0.f;
#pragma unroll
            for (int nn = 0; nn < 4; ++nn) { o[qt][nn] = o[qt][nn] - mu; s2 += (o[qt][nn][0] * o[qt][nn][0] + o[qt][nn][1] * o[qt][nn][1]) + (o[qt][nn][2] * o[qt][nn][2] + o[qt][nn][3] * o[qt][nn][3]); }
            s2 += shx(s2, 16, lane); s2 += shx(s2, 32, lane); const float rs = rsqrtf(s2 * (1.f / 64.f) + 1e-5f);
#pragma unroll
            for (int nn = 0; nn < 4; ++nn) { const int col = h * 64 + 16 * nn + 4 * quad; const u32x2 gw = *(const u32x2*)(proj + qrow * NIN + C_GR + col);
                const float g0 = __uint_as_float(gw.x << 16), g1 = __uint_as_float(gw.x & 0xffff0000u), g2 = __uint_as_float(gw.y << 16), g3 = __uint_as_float(gw.y & 0xffff0000u);
                const f32x4 v = o[qt][nn] * rs; u32x2 w; w.x = pk2(pg8::silu_mul(g0, v[0]), pg8::silu_mul(g1, v[1])); w.y = pk2(pg8::silu_mul(g2, v[2]), pg8::silu_mul(g3, v[3]));
                *(u32x2*)(mix + qrow * DM + MX_R + col) = w; }
        }
        }
    }
}
struct TileLd { bf16x8 k[2][2]; u32x4 v[4]; };
template <bool EDGE>
__device__ __forceinline__ void tile_load(TileLd& L, const bf16_t* kp, const bf16_t* vp, int S, int pos0, int dil, int k0, int lane) {
    asm volatile("" : "+s"(k0), "+s"(pos0));
    const int i16 = lane & 15, quad = lane >> 4;
#pragma unroll
    for (int st = 0; st < 2; ++st) { int pos = pos0 + dil * (k0 + 16 * st + i16); if (EDGE) pos = min(max(pos, 0), S - 1);
        const bf16_t* p = kp + (long)pos * NIN + quad * 8; L.k[st][0] = *(const bf16x8*)p; L.k[st][1] = *(const bf16x8*)(p + 32); }
#pragma unroll
    for (int i = 0; i < 4; ++i) { int pos = pos0 + dil * (k0 + 8 * i + (lane >> 3)); if (EDGE) pos = min(max(pos, 0), S - 1);
        L.v[i] = *(const u32x4*)(vp + (long)pos * NIN + (lane & 7) * 8); }
}
template <int G, bool EDGE>
__device__ __forceinline__ void attn_tile(const TileLd& L, const int (&klo)[G], const int (&kspan)[G], int k0, int R, const int (&ua)[G], const LAS float* lut, int lutstride,
                                          LAS unsigned char* vimg, int lane, const bf16x8 (&q)[G][2], f32x4 (&o)[G][4], float (&m)[G], float (&l)[G]) {
    asm volatile("" : "+s"(k0));
    const int quad = lane >> 4; const f32x4 z4 = {0.f, 0.f, 0.f, 0.f};
    bf16x8 vf[4]; stage_v_regs(L.v, vimg, lane, vf);
    constexpr float C2 = 0.125f * LOG2E, THR = 6.0f;
    const int kb = k0 + 4 * quad;
#pragma unroll
    for (int g = 0; g < G; ++g) {
        const LAS float* lutb = lut + (kb - ua[g] + R);
        float sc[8]; float mx = -1e30f;
#pragma unroll
        for (int st = 0; st < 2; ++st) { f32x4 s = MFMA16(L.k[st][0], q[g][0], z4); s = MFMA16(L.k[st][1], q[g][1], s);
#pragma unroll
            for (int jj = 0; jj < 4; ++jj) { const int c = 16 * st + jj; const bool v = (unsigned)(kb - klo[g] + c) <= (unsigned)kspan[g];
                float x = s[jj] * C2 + lutb[g * lutstride + c]; x = v ? x : -1e30f; sc[4 * st + jj] = x; mx = fmaxf(mx, x); } }
        if (__any(mx - m[g] > THR)) {
            mx = fmaxf(mx, shx(mx, 16, lane)); mx = fmaxf(mx, shx(mx, 32, lane));
            const float mn = fmaxf(m[g], mx), al = ex2(m[g] - mn); m[g] = mn; l[g] *= al;
#pragma unroll
            for (int nn = 0; nn < 4; ++nn) o[g][nn] = o[g][nn] * al;
        }
        const float mn = m[g]; float p[8], ps = 0.f;
#pragma unroll
        for (int e = 0; e < 8; ++e) { p[e] = ex2(sc[e] - mn); ps += p[e]; }
        l[g] += ps;
        const u32x4 pw = {pg8::cvt_pk_vis(p[0], p[1]), pg8::cvt_pk_vis(p[2], p[3]), pg8::cvt_pk_vis(p[4], p[5]), pg8::cvt_pk_vis(p[6], p[7])}; const bf16x8 pf = __builtin_bit_cast(bf16x8, pw);
#pragma unroll
        for (int nn = 0; nn < 4; ++nn) o[g][nn] = MFMA16(vf[nn], pf, o[g][nn]);
    }
}
__device__ __forceinline__ void a_tile_params(int tt, int& br, int& dil, int& k0) {
    if (tt < 12) { br = 0; dil = 1; k0 = -64 + 32 * tt; } else if (tt < 18) { br = 1; dil = 4; k0 = -64 + 32 * (tt - 12); } else { br = 2; dil = 16; k0 = -64 + 32 * (tt - 18); }
}
template <bool EDGE>
__device__ __forceinline__ void mixer_a_item(const bf16_t* kp, const bf16_t* vp, int S, int pos0, const LAS float* lut, LAS unsigned char* vimg, int lane,
                                             const bf16x8 (&q)[1][2], f32x4 (&o)[1][4], float (&m)[1], float (&l)[1]) {
    const int i16 = lane & 15;
    TileLd ta, tb; tile_load<EDGE>(ta, kp, vp, S, pos0, 1, -64, lane);
#define A_STEP(CUR, NXT, TT, PF) do { int br_, dil_, k0_; a_tile_params((TT), br_, dil_, k0_); \
        if (PF) { int br1_, dil1_, k01_; a_tile_params((TT) + 1, br1_, dil1_, k01_); tile_load<EDGE>(NXT, kp, vp, S, pos0, dil1_, k01_, lane); } \
        const int ua_ = i16 * (16 / dil_); const int kmin_ = (dil_ == 1 ? -pos0 : (dil_ == 4 ? -(pos0 >> 2) : -(pos0 >> 4))), kmax_ = (dil_ == 1 ? S - 1 - pos0 : (dil_ == 4 ? (S - 1 - pos0) >> 2 : (S - 1 - pos0) >> 4)); \
        const int klo_ = max(ua_ - 64, kmin_), khi_ = min(ua_ + 64, kmax_); \
        const int kl1_[1] = {klo_}, ks1_[1] = {khi_ - klo_}, ua1_[1] = {ua_}; \
        attn_tile<1, EDGE>(CUR, kl1_, ks1_, k0_, 64, ua1_, lut + br_ * 129, 0, vimg, lane, q, o, m, l); } while (0)
#pragma unroll 1
    for (int tt = 0; tt < 22; tt += 2) { A_STEP(ta, tb, tt, true); A_STEP(tb, ta, tt + 1, true); }
    A_STEP(ta, tb, 22, false);
#undef A_STEP
}
__device__ __forceinline__ void mixer_a(Frame& F, const Trunk& T) {
    const bf16_t* proj = (const bf16_t*)(F.ws + WS_PROJ); bf16_t* mix = (bf16_t*)(F.ws + WS_MIX); const float* lutA = (const float*)(F.ws + WS_LUTA);
    LAS unsigned char* vimg = F.lds + F.wave * WLDS; LAS float* lut = (LAS float*)(vimg + 32 * VPITCH);
    const int lane = F.lane, i16 = lane & 15, quad = lane >> 4; const f32x4 z4 = {0.f, 0.f, 0.f, 0.f};
    const int NIT = (MT / 16) * 12, per = (NIT + F.NGW - 1) / F.NGW, bps = T.S / 256;
    const bool xmap = (F.G == 256);
    for (int j = 0; j < per; ++j) {
        int h, rest;
        if (xmap) { h = j; rest = ((F.bx & 7) * 16) * 16 + (F.bx >> 3) * NWAVES + F.wave; }
        else { const int it = (F.bx * per + j) * NWAVES + F.wave; if (it >= NIT) break; h = it / (MT / 16); rest = it % (MT / 16); }
        const int r = rest & 15, gblk = rest >> 4, b = gblk / bps, P0 = (gblk % bps) * 256;
        const size_t rowb = (size_t)b * T.S; const int posq = P0 + r + 16 * i16;
        const bf16_t* kp = proj + rowb * NIN + C_KA + h * 64; const bf16_t* vp = proj + rowb * NIN + C_VA + h * 64;
        bf16x8 q[1][2]; { const bf16_t* qp = proj + (rowb + posq) * NIN + C_QA + h * 64 + quad * 8; q[0][0] = *(const bf16x8*)qp; q[0][1] = *(const bf16x8*)(qp + 32); }
        for (int i = lane; i < 387; i += 64) lut[i] = lutA[h * 387 + i];
        asm volatile("s_waitcnt lgkmcnt(0)" ::: "memory");
        f32x4 o[1][4] = {{z4, z4, z4, z4}}; float m[1] = {-1e20f}, l[1] = {0.f};
        if (P0 >= 1024 && P0 + 1792 <= T.S) mixer_a_item<false>(kp, vp, T.S, P0 + r, lut, vimg, lane, q, o, m, l);
        else mixer_a_item<true>(kp, vp, T.S, P0 + r, lut, vimg, lane, q, o, m, l);
        float lt = l[0]; lt += shx(lt, 16, lane); lt += shx(lt, 32, lane); const float inv = 1.0f / lt;
#pragma unroll
        for (int nn = 0; nn < 4; ++nn) { const f32x4 v = o[0][nn] * inv; u32x2 w; w.x = pk2(v[0], v[1]); w.y = pk2(v[2], v[3]);
            *(u32x2*)(mix + (rowb + posq) * DM + MX_A + h * 64 + 16 * nn + 4 * quad) = w; }
    }
}
constexpr int A2_WL = 6400, A2_XO = 8 * A2_WL, A2_XP = 272, A2_XM = A2_XO + 256 * A2_XP, A2_XL = A2_XM + 1024;
static_assert(A2_XL + 1024 <= RING_BYTES, "mixer A exchange area inside the ring region");
template <bool EDGE>
__device__ __forceinline__ void a2_pass1(const bf16_t* kp, const bf16_t* vp, int S, int pos0, const LAS float* lut, LAS unsigned char* vimg, int lane,
                                         const bf16x8 (&q)[2][2], f32x4 (&o)[2][4], float (&m)[2], float (&l)[2]) {
    const int i16 = lane & 15;
    const int ua[2] = {i16, i16 + 16};
    const int klo[2] = {max(ua[0] - 64, -pos0), max(ua[1] - 64, -pos0)}, kspan[2] = {min(ua[0] + 64, S - 1 - pos0) - klo[0], min(ua[1] + 64, S - 1 - pos0) - klo[1]};
    TileLd ta, tb; tile_load<EDGE>(ta, kp, vp, S, pos0, 1, -64, lane);
#define P1_STEP(CUR, NXT, TT, PF) do { if (PF) tile_load<EDGE>(NXT, kp, vp, S, pos0, 1, -64 + 32 * ((TT) + 1), lane); \
        attn_tile<2, EDGE>(CUR, klo, kspan, -64 + 32 * (TT), 64, ua, lut, 0, vimg, lane, q, o, m, l); } while (0)
#pragma unroll 1
    for (int t = 0; t < 4; t += 2) { P1_STEP(ta, tb, t, true); P1_STEP(tb, ta, t + 1, true); }
    P1_STEP(ta, tb, 4, false);
#undef P1_STEP
}
template <bool EDGE>
__device__ __forceinline__ void a2_pass2(const bf16_t* kp, const bf16_t* vp, int S, int pos0, const LAS float* lut, LAS unsigned char* vimg, int lane,
                                         const bf16x8 (&q)[2][2], f32x4 (&o)[2][4], float (&m)[2], float (&l)[2]) {
    const int i16 = lane & 15;
    TileLd ta, tb; tile_load<EDGE>(ta, kp, vp, S, pos0, 4, -64, lane);
#define LDS_(NXT, s_) do { const int s__ = (s_); const int pb_ = s__ < 11 ? pos0 : pos0 + 8, dl_ = s__ < 6 ? 4 : 16, kk_ = -64 + 32 * (s__ < 6 ? s__ : (s__ < 11 ? s__ - 6 : s__ - 11)); \
        tile_load<EDGE>(NXT, kp, vp, S, pb_, dl_, kk_, lane); } while (0)
    {
        const int ua1[2] = {4 * i16, 4 * i16 + 2}; const int kmin1 = -(pos0 >> 2), kmax1 = (S - 1 - pos0) >> 2;
        const int klo1[2] = {max(ua1[0] - 64, kmin1), max(ua1[1] - 64, kmin1)}, ksp1[2] = {min(ua1[0] + 64, kmax1) - klo1[0], min(ua1[1] + 64, kmax1) - klo1[1]};
#define CP1(CUR, t_) attn_tile<2, EDGE>(CUR, klo1, ksp1, -64 + 32 * (t_), 64, ua1, lut + 129, 0, vimg, lane, q, o, m, l)
#pragma unroll 1
        for (int s_ = 0; s_ < 6; s_ += 2) { LDS_(tb, s_ + 1); CP1(ta, s_); LDS_(ta, s_ + 2); CP1(tb, s_ + 1); }
#undef CP1
    }
    const int ua2[1] = {i16};
    {
        const int klo2[1] = {max(i16 - 64, -(pos0 >> 4))}, ksp2[1] = {min(i16 + 64, (S - 1 - pos0) >> 4) - klo2[0]};
        const bf16x8 q1[1][2] = {{q[0][0], q[0][1]}}; f32x4 o1[1][4] = {{o[0][0], o[0][1], o[0][2], o[0][3]}}; float m1[1] = {m[0]}, l1[1] = {l[0]};
#define CP2(CUR, t_) attn_tile<1, EDGE>(CUR, klo2, ksp2, -64 + 32 * (t_), 64, ua2, lut + 258, 0, vimg, lane, q1, o1, m1, l1)
#pragma unroll 1
        for (int s_ = 6; s_ < 10; s_ += 2) { LDS_(tb, s_ + 1); CP2(ta, s_ - 6); LDS_(ta, s_ + 2); CP2(tb, s_ - 5); }
        LDS_(tb, 11); CP2(ta, 4);
#undef CP2
#pragma unroll
        for (int nn = 0; nn < 4; ++nn) o[0][nn] = o1[0][nn];
        m[0] = m1[0]; l[0] = l1[0];
    }
    {
        const int klo2[1] = {max(i16 - 64, -((pos0 + 8) >> 4))}, ksp2[1] = {min(i16 + 64, (S - 9 - pos0) >> 4) - klo2[0]};
        const bf16x8 q1[1][2] = {{q[1][0], q[1][1]}}; f32x4 o1[1][4] = {{o[1][0], o[1][1], o[1][2], o[1][3]}}; float m1[1] = {m[1]}, l1[1] = {l[1]};
#define CP2(CUR, t_) attn_tile<1, EDGE>(CUR, klo2, ksp2, -64 + 32 * (t_), 64, ua2, lut + 258, 0, vimg, lane, q1, o1, m1, l1)
#pragma unroll 1
        for (int s_ = 11; s_ < 15; s_ += 2) { LDS_(ta, s_ + 1); CP2(tb, s_ - 11); LDS_(tb, s_ + 2); CP2(ta, s_ - 10); }
        CP2(tb, 4);
#undef CP2
#pragma unroll
        for (int nn = 0; nn < 4; ++nn) o[1][nn] = o1[0][nn];
        m[1] = m1[0]; l[1] = l1[0];
    }
#undef LDS_
}
__device__ __forceinline__ void mixer_a2(Frame& F, const Trunk& T) {
    const bf16_t* proj = (const bf16_t*)(F.ws + WS_PROJ); bf16_t* mix = (bf16_t*)(F.ws + WS_MIX); const float* lutA = (const float*)(F.ws + WS_LUTA);
    LAS unsigned char* vimg = F.lds + F.wave * A2_WL; LAS float* lut = (LAS float*)(vimg + 32 * VPITCH);
    LAS unsigned char* XO = F.lds + A2_XO; LAS float* XM = (LAS float*)(F.lds + A2_XM); LAS float* XL = (LAS float*)(F.lds + A2_XL);
    const int lane = F.lane, i16 = lane & 15, quad = lane >> 4; const f32x4 z4 = {0.f, 0.f, 0.f, 0.f};
    const int bps = T.S / 256, lw = F.bx >> 3;
#pragma unroll 1
    for (int j = 0; j < 6; ++j) {
        const int h = 2 * j + (lw >> 4), gblk = (F.bx & 7) * 16 + (lw & 15), b = gblk / bps, P0 = (gblk % bps) * 256;
        const size_t rowb = (size_t)b * T.S;
        const bf16_t* kp = proj + rowb * NIN + C_KA + h * 64; const bf16_t* vp = proj + rowb * NIN + C_VA + h * 64;
        for (int i = lane; i < 387; i += 64) lut[i] = lutA[h * 387 + i];
        asm volatile("s_waitcnt lgkmcnt(0)" ::: "memory");
        {
            const int pos0 = P0 + 32 * F.wave;
            bf16x8 q[2][2]; f32x4 o[2][4]; float m[2], l[2];
#pragma unroll
            for (int g = 0; g < 2; ++g) { const bf16_t* qp = proj + (rowb + pos0 + 16 * g + i16) * NIN + C_QA + h * 64 + quad * 8; q[g][0] = *(const bf16x8*)qp; q[g][1] = *(const bf16x8*)(qp + 32);
                o[g][0] = z4; o[g][1] = z4; o[g][2] = z4; o[g][3] = z4; m[g] = -1e20f; l[g] = 0.f; }
            if (pos0 >= 64 && pos0 + 96 <= T.S) a2_pass1<false>(kp, vp, T.S, pos0, lut, vimg, lane, q, o, m, l);
            else a2_pass1<true>(kp, vp, T.S, pos0, lut, vimg, lane, q, o, m, l);
#pragma unroll
            for (int g = 0; g < 2; ++g) { float lt = l[g]; lt += shx(lt, 16, lane); lt += shx(lt, 32, lane);
                const int qi = 32 * F.wave + 16 * g + i16;
#pragma unroll
                for (int nn = 0; nn < 4; ++nn) *(LAS f32x4*)(XO + qi * A2_XP + (16 * nn + 4 * quad) * 4) = o[g][nn];
                if (quad == 0) { XM[qi] = m[g]; XL[qi] = lt; } }
        }
        __syncthreads();
        {
            const int pos0 = P0 + F.wave;
            bf16x8 q[2][2]; f32x4 o[2][4]; float m[2], l[2];
#pragma unroll
            for (int g = 0; g < 2; ++g) { const int qi = F.wave + 8 * g + 16 * i16;
                const bf16_t* qp = proj + (rowb + P0 + qi) * NIN + C_QA + h * 64 + quad * 8; q[g][0] = *(const bf16x8*)qp; q[g][1] = *(const bf16x8*)(qp + 32);
#pragma unroll
                for (int nn = 0; nn < 4; ++nn) o[g][nn] = *(const LAS f32x4*)(XO + qi * A2_XP + (16 * nn + 4 * quad) * 4);
                m[g] = XM[qi]; l[g] = quad == 0 ? XL[qi] : 0.f; }
            if (P0 >= 1024 && P0 + 1792 <= T.S) a2_pass2<false>(kp, vp, T.S, pos0, lut, vimg, lane, q, o, m, l);
            else a2_pass2<true>(kp, vp, T.S, pos0, lut, vimg, lane, q, o, m, l);
#pragma unroll
            for (int g = 0; g < 2; ++g) { float lt = l[g]; lt += shx(lt, 16, lane); lt += shx(lt, 32, lane); const float inv = 1.0f / lt;
                const size_t orow = rowb + P0 + F.wave + 8 * g + 16 * i16;
#pragma unroll
                for (int nn = 0; nn < 4; ++nn) { const f32x4 v = o[g][nn] * inv; u32x2 w; w.x = pk2(v[0], v[1]); w.y = pk2(v[2], v[3]);
                    *(u32x2*)(mix + orow * DM + MX_A + h * 64 + 16 * nn + 4 * quad) = w; } }
        }
        __syncthreads();
    }
}
template <bool EDGE>
__device__ __forceinline__ void mixer_c_item(const bf16_t* kp, const bf16_t* vp, int S, int P0, const LAS float* lut, LAS unsigned char* vimg, int lane,
                                             const bf16x8 (&q)[3][2], f32x4 (&o)[3][4], float (&m)[3], float (&l)[3]) {
    const int i16 = lane & 15;
    const int klo_1 = max(i16 - 128, -P0), kspan_1 = min(i16 + 128, S - 1 - P0) - klo_1; const int klo_c[3] = {klo_1, klo_1, klo_1}, kspan_c[3] = {kspan_1, kspan_1, kspan_1}, ua_c[3] = {i16, i16, i16};
    TileLd ta, tb; tile_load<EDGE>(ta, kp, vp, S, P0, 1, -128, lane);
#define C_STEP(CUR, NXT, TT, PF) do { if (PF) tile_load<EDGE>(NXT, kp, vp, S, P0, 1, -128 + 32 * ((TT) + 1), lane); \
        attn_tile<3, EDGE>(CUR, klo_c, kspan_c, -128 + 32 * (TT), 128, ua_c, lut, 257, vimg, lane, q, o, m, l); } while (0)
#pragma unroll 1
    for (int t = 0; t < 8; t += 2) { C_STEP(ta, tb, t, true); C_STEP(tb, ta, t + 1, true); }
    C_STEP(ta, tb, 8, false);
#undef C_STEP
}
__device__ __forceinline__ void mixer_c(Frame& F, const Trunk& T, int layer) {
    const bf16_t* proj = (const bf16_t*)(F.ws + WS_PROJ); bf16_t* mix = (bf16_t*)(F.ws + WS_MIX); const float* lutC = (const float*)(F.ws + WS_LUTC);
    LAS unsigned char* vimg = F.lds + F.wave * WLDS; LAS float* lut = (LAS float*)(vimg + 32 * VPITCH);
    const int lane = F.lane, i16 = lane & 15, quad = lane >> 4; const f32x4 z4 = {0.f, 0.f, 0.f, 0.f};
    const int NIT = (MT / 16) * 4, per = (NIT + F.NGW - 1) / F.NGW, bps = T.S / 16;
    const bool xmap = (F.G == 256);
    for (int j = 0; j < per; ++j) {
        int kvh, rest;
        if (xmap) { kvh = j; rest = (F.bx & 7) * 256 + (F.bx >> 3) * NWAVES + F.wave; }
        else { const int it = F.gw * per + j; if (it >= NIT) break; kvh = it / (MT / 16); rest = it % (MT / 16); }
        const int b = rest / bps, P0 = (rest % bps) * 16;
        const size_t rowb = (size_t)b * T.S; const int posq = P0 + i16;
        const bf16_t* kp = proj + rowb * NIN + C_KC + kvh * 64; const bf16_t* vp = proj + rowb * NIN + C_VC + kvh * 64;
        for (int i = lane; i < 771; i += 64) lut[i] = lutC[kvh * 771 + i];
        asm volatile("s_waitcnt lgkmcnt(0)" ::: "memory");
        bf16x8 q[3][2]; f32x4 o[3][4]; float m[3], l[3], snk[3];
#pragma unroll
        for (int g = 0; g < 3; ++g) { const bf16_t* qp = proj + (rowb + posq) * NIN + C_QC + (3 * kvh + g) * 64 + quad * 8; q[g][0] = *(const bf16x8*)qp; q[g][1] = *(const bf16x8*)(qp + 32);
            o[g][0] = z4; o[g][1] = z4; o[g][2] = z4; o[g][3] = z4; snk[g] = ((const float*)(F.ws + WS_PAR))[32 + layer * 12 + 3 * kvh + g]; m[g] = snk[g]; l[g] = 0.f; }
        if (P0 >= 128 && P0 + 160 <= T.S) mixer_c_item<false>(kp, vp, T.S, P0, lut, vimg, lane, q, o, m, l);
        else mixer_c_item<true>(kp, vp, T.S, P0, lut, vimg, lane, q, o, m, l);
#pragma unroll
        for (int g = 0; g < 3; ++g) { float lt = l[g]; lt += shx(lt, 16, lane); lt += shx(lt, 32, lane); lt += ex2(snk[g] - m[g]); const float inv = 1.0f / lt;
#pragma unroll
            for (int nn = 0; nn < 4; ++nn) { const f32x4 v = o[g][nn] * inv; u32x2 w; w.x = pk2(v[0], v[1]); w.y = pk2(v[2], v[3]);
                *(u32x2*)(mix + (rowb + posq) * DM + MX_C + (3 * kvh + g) * 64 + 16 * nn + 4 * quad) = w; } }
    }
}

struct Args { const float* in[14]; float* out; unsigned char* ws; int ph_lo, ph_hi; };
constexpr int NPHASES = 32;
__global__ void __launch_bounds__(NTHR, 2) mega_fwd(Args args) {
    extern __shared__ __attribute__((aligned(16))) unsigned char lds_raw[];
#define MKF Frame F; { int t_ = MYTID; asm volatile("" : "+v"(t_)); int b_ = blockIdx.x; asm volatile("" : "+s"(b_)); F.lds = (LAS unsigned char*)lds_raw; F.tid = t_; F.lane = t_ & 63; \
    F.wave = __builtin_amdgcn_readfirstlane(t_ >> 6); F.G = gridDim.x; F.bx = b_; F.gw = b_ * NWAVES + F.wave; F.NGW = F.G * NWAVES; { size_t z_ = 0; asm volatile("" : "+s"(z_)); F.ws = args.ws + z_; } }
#define MKT Trunk T; T.x = tr ? args.in[1] : args.in[0]; T.out = args.out + (size_t)tr * MT * DM; T.nseq = tr ? 2 : 4; T.S = tr ? 16384 : 8192;
#define OPQ size_t zo_ = 0; asm volatile("" : "+s"(zo_)); unsigned char* wsb_ = args.ws + zo_;
#define WSP(off) (wsb_ + (off))
    const int wave_s = __builtin_amdgcn_readfirstlane((int)threadIdx.x >> 6);
#define MYTID ({ unsigned z__ = 0u; asm volatile("" : "+s"(z__)); wave_s * 64 + (int)__builtin_amdgcn_mbcnt_hi(~0u, __builtin_amdgcn_mbcnt_lo(~0u, z__)); })
    const int lo = args.ph_lo, hi = args.ph_hi; int ph = 0;
#if !MK_PER_PHASE
    if (MYTID < 16) ((LAS unsigned*)(lds_raw + RING_BYTES))[MYTID] = 0u;
    __syncthreads();
    (void)xcd_barrier_post((unsigned*)args.ws, (volatile LAS unsigned*)((LAS unsigned char*)lds_raw + RING_BYTES), MYTID == 0);
#endif
#define XBAR do { XcdBarrier b_; b_.bar = (unsigned*)args.ws; b_.x = xb_xcc_id(); b_.st = (volatile LAS unsigned*)((LAS unsigned char*)lds_raw + RING_BYTES); xcd_barrier(b_, MYTID == 0); } while (0)
#define PH_ON (ph >= lo && ph < hi)
#if MK_PER_PHASE
#define PH_END do { ++ph; } while (0)
#else
#define PH_END do { if (ph >= lo && ph + 1 < hi) { if (ph == 0) cg::this_grid().sync(); else XBAR; } ++ph; } while (0)
#endif
    if (PH_ON) { MKF; const int tr = 0; MKT; weights_prologue(F, args.in); trunk_prologue(F, T); }
    PH_END;
#pragma unroll 1
    for (int tr = 0; tr < 2; ++tr) {
#pragma unroll 1
        for (int layer = 0; layer < NL; ++layer) {
            if (PH_ON) { OPQ; pg8::Gemm g{(const bf16_t*)WSP(WS_XB), (const bf16_t*)WSP(WS_W + (size_t)layer * W_LAYER + W_IN), MT, NIN, DM}; pg8::StaticOrder S; S.init(MT, NIN, gridDim.x, (int)blockIdx.x);
                pg8::EpiScaleBf16 E{(bf16_t*)WSP(WS_PROJ), NIN, (const float*)WSP(WS_PART), MT};
                for (int rp = 0; rp < RPT_GEMM; ++rp) pg8::gemm_phase<pg8::EpiScaleBf16, pg8::StaticOrder, PG8_ALIGN, PG8_SP2>((LAS unsigned char*)lds_raw, g, S, E, MYTID); }
            PH_END;
            if (PH_ON) { MKF; MKT; ret_chunk_states(F, T, layer); }
            PH_END;
            if (PH_ON) { MKF; MKT; ret_scan(F, T, layer); for (int rp = 0; rp < RPT_AC; ++rp) { if (F.G == 256) mixer_a2(F, T); else mixer_a(F, T); mixer_c(F, T, layer); } }
            PH_END;
            if (PH_ON) { MKF; MKT; for (int rp = 0; rp < RPT_B3; ++rp) ret_output(F, T, layer); }
            PH_END;
            if (PH_ON) { OPQ; pg8::Gemm g{(const bf16_t*)WSP(WS_MIX), (const bf16_t*)WSP(WS_W + (size_t)layer * W_LAYER + W_OUT), MT, DM, DM}; pg8::StaticOrder S; S.init(MT, DM, gridDim.x, (int)blockIdx.x);
                pg8::EpiResid E{(bf16_t*)WSP(WS_XB), (float*)WSP(WS_PART), MT};
                pg8::gemm_phase<pg8::EpiResid, pg8::StaticOrder, PG8_ALIGN, PG8_SP2>((LAS unsigned char*)lds_raw, g, S, E, MYTID); }
            PH_END;
            if (PH_ON) { OPQ; pg8::Gemm g{(const bf16_t*)WSP(WS_XB), (const bf16_t*)WSP(WS_W + (size_t)layer * W_LAYER + W_GU), MT, NGU, DM}; pg8::StaticOrder S; S.init(MT, NGU, gridDim.x, (int)blockIdx.x);
                pg8::EpiSwiGLU E{(bf16_t*)WSP(WS_H), DFF, (const float*)WSP(WS_PART), MT};
                for (int rp = 0; rp < RPT_GEMM; ++rp) pg8::gemm_phase<pg8::EpiSwiGLU, pg8::StaticOrder, PG8_ALIGN, PG8_SP2>((LAS unsigned char*)lds_raw, g, S, E, MYTID); }
            PH_END;
            if (PH_ON) { OPQ; pg8::Gemm g{(const bf16_t*)WSP(WS_H), (const bf16_t*)WSP(WS_W + (size_t)layer * W_LAYER + W_DN), MT, DM, DFF}; pg8::StaticOrder S; S.init(MT, DM, gridDim.x, (int)blockIdx.x);
                pg8::EpiResid E{(bf16_t*)WSP(WS_XB), (float*)WSP(WS_PART), MT};
                pg8::gemm_phase<pg8::EpiResid, pg8::StaticOrder, PG8_ALIGN, PG8_SP2>((LAS unsigned char*)lds_raw, g, S, E, MYTID); }
            PH_END;
        }
        if (PH_ON) { MKF; MKT; final_norm(F, T); }
        PH_END;
        if (tr == 0) { if (PH_ON) { MKF; Trunk T; T.x = args.in[1]; T.out = args.out + (size_t)MT * DM; T.nseq = 2; T.S = 16384; trunk_prologue(F, T); } PH_END; }
    }
}

extern "C" void kernel_launch(void* const* d_in, const int* in_sizes, int n_in, void* d_out, int out_size, void* d_ws, size_t ws_size, hipStream_t stream) {
    static int grid = 0;
    if (grid == 0) {
        if (n_in != 14 || in_sizes[0] != MT * DM || in_sizes[1] != MT * DM || out_size != 2 * MT * DM || ws_size < WS_END) {
            fprintf(stderr, "kernel_launch: unexpected shapes (n_in %d, in0 %d, out %d, ws %zu)\n", n_in, n_in > 0 ? in_sizes[0] : -1, out_size, ws_size); grid = -1; return; }
        int dev = 0, cus = 0, per_cu = 0;
        hipGetDevice(&dev); hipDeviceGetAttribute(&cus, hipDeviceAttributeMultiprocessorCount, dev);
        if (hipFuncSetAttribute((const void*)mega_fwd, hipFuncAttributeMaxDynamicSharedMemorySize, LDS_BYTES) != hipSuccess) { fprintf(stderr, "kernel_launch: hipFuncSetAttribute failed\n"); grid = -1; return; }
        if (hipOccupancyMaxActiveBlocksPerMultiprocessor(&per_cu, (const void*)mega_fwd, NTHR, LDS_BYTES) != hipSuccess || per_cu < 1) per_cu = 1;
        (void)hipGetLastError();
        grid = cus * per_cu;
    }
    if (grid < 0) return;
    Args a{};
    for (int i = 0; i < 14; ++i) a.in[i] = (const float*)d_in[i];
    a.out = (float*)d_out; a.ws = (unsigned char*)d_ws;
#if MK_PER_PHASE
    for (int p = 0; p < NPHASES; ++p) { a.ph_lo = p; a.ph_hi = p + 1; hipLaunchKernelGGL(mega_fwd, dim3(grid), dim3(NTHR), LDS_BYTES, stream, a); }
#else
    a.ph_lo = 0; a.ph_hi = NPHASES;
    if (hipMemsetAsync(d_ws, 0, 16384, stream) != hipSuccess) { fprintf(stderr, "kernel_launch: memset of the barrier words failed\n"); return; }
    void* params[] = {&a};
    hipError_t e = hipLaunchCooperativeKernel((const void*)mega_fwd, dim3(grid), dim3(NTHR), params, LDS_BYTES, stream);
    if (e != hipSuccess) fprintf(stderr, "kernel_launch: cooperative launch failed: %s (grid %d)\n", hipGetErrorString(e), grid);
#endif
}
```
